# Optimizing an MI355X kernel written in HIP

```python
import jax
import jax.numpy as jnp
from jax import lax
import numpy as np

D_MODEL = 1024
BATCH = 8
SEQ = 2048
DEPTH = 1

MIX_WIDTH = D_MODEL
HEAD_DIM = 64
NSA_WIDTH = MIX_WIDTH // 2
CONV_WIDTH = MIX_WIDTH - NSA_WIDTH
NSA_HEADS = NSA_WIDTH // HEAD_DIM
NSA_KV_HEADS = 2
GQA_REP = NSA_HEADS // NSA_KV_HEADS
N_NSA_BRANCH = 3
CMP_LEN = 32
CMP_STRIDE = 16
SEL_LEN = 64
SEL_TOPN = 16
WINDOW = 512
Q_BLOCK = 64
FORCE_BONUS = 1.0e4
CONV_TAPS = 31
PEER_HEADS = 8
PEER_NKEYS = 128
PEER_EXPERTS = PEER_NKEYS * PEER_NKEYS
PEER_QDIM = 256
PEER_TOPK = 16
PEER_TOK_BLOCK = 128
NORM_EPS = 1e-6
NEG_INF = -1e30

N_Q_COLS = NSA_HEADS * HEAD_DIM
N_KV_COLS = 2 * N_NSA_BRANCH * NSA_KV_HEADS * HEAD_DIM
N_GATE_COLS = NSA_HEADS * N_NSA_BRANCH
N_GLU_COLS = 2 * CONV_WIDTH
IN_COLS = N_Q_COLS + N_KV_COLS + N_GATE_COLS + N_GLU_COLS

kernel_name = 'hybrid_nsa_conformer_peer_layer'


def rmsnorm(x, g):
    xf = x.astype(jnp.float32)
    y = xf * lax.rsqrt(jnp.mean(xf * xf, axis=-1, keepdims=True) + NORM_EPS)
    return (y * g).astype(x.dtype)


def modulate(h, shift, scale):
    return h * (1.0 + scale[:, None, :]) + shift[:, None, :]


def masked_softmax(s, mask):
    p = jax.nn.softmax(jnp.where(mask, s, NEG_INF), axis=-1)
    return jnp.where(mask, p, 0.0)


def alibi_slopes():
    h = np.arange(1, NSA_HEADS + 1, dtype=np.float32)
    return (2.0 ** (-8.0 * h / NSA_HEADS)).astype(np.float32).reshape(NSA_KV_HEADS, GQA_REP)


def nsa_mixer(q, kv, gate_logits, cmp_pe_k, cmp_pe_v, w_cmp_k, w_cmp_v, qk_norm_g):
    B, S = q.shape[0], q.shape[1]
    G, R, hd = NSA_KV_HEADS, GQA_REP, HEAD_DIM
    slopes = jnp.asarray(alibi_slopes())
    t_pos = np.arange(S)
    q = rmsnorm(q, qk_norm_g[0]) * (hd ** -0.5)
    q = q.reshape(B, S, G, R, hd).transpose(0, 2, 3, 1, 4)
    kv = kv.transpose(2, 0, 3, 1, 4)
    k_cmp, v_cmp, k_slc, v_slc, k_win, v_win = kv[0], kv[1], kv[2], kv[3], kv[4], kv[5]

    n_cmp = (S - CMP_LEN) // CMP_STRIDE + 1
    blk_tok = np.arange(n_cmp)[:, None] * CMP_STRIDE + np.arange(CMP_LEN)[None, :]
    kc = jnp.einsum('bgnld,lde->bgne', k_cmp[:, :, blk_tok] + cmp_pe_k, w_cmp_k)
    vc = jnp.einsum('bgnld,lde->bgne', v_cmp[:, :, blk_tok] + cmp_pe_v, w_cmp_v)
    kc = rmsnorm(kc, qk_norm_g[1])
    blk_end = blk_tok[:, -1]
    cdist = (t_pos[:, None] - blk_end[None, :]).astype(np.float32)
    s_cmp = jnp.einsum('bgrtd,bgnd->bgrtn', q, kc).astype(jnp.float32) - slopes[:, :, None, None] * cdist
    p_cmp = masked_softmax(s_cmp, cdist >= 0)
    o_cmp = jnp.einsum('bgrtn,bgnd->bgrtd', p_cmp.astype(vc.dtype), vc)

    n_sel = S // SEL_LEN
    top_n = min(SEL_TOPN, n_sel)
    sel_start = np.arange(n_sel) * SEL_LEN
    overlap = np.clip(np.minimum(blk_tok[:, -1:] + 1, sel_start[None, :] + SEL_LEN)
                      - np.maximum(blk_tok[:, :1], sel_start[None, :]), 0, None).astype(np.float32) / CMP_LEN
    imp = jnp.einsum('bgrtn,nj->bgtj', p_cmp, overlap)
    t_blk = t_pos // SEL_LEN
    j = np.arange(n_sel)
    valid = j[None, :] <= t_blk[:, None]
    forced = ((j[None, :] == 0) | (j[None, :] == t_blk[:, None]) | (j[None, :] == t_blk[:, None] - 1)).astype(np.float32)
    imp = jnp.where(valid, imp + FORCE_BONUS * forced, -1.0)
    _, sel_idx = lax.top_k(imp, top_n)

    ks_blocks = rmsnorm(k_slc, qk_norm_g[2]).reshape(B, G, n_sel, SEL_LEN, hd)
    vs_blocks = v_slc.reshape(B, G, n_sel, SEL_LEN, hd)
    kw_pad = jnp.pad(rmsnorm(k_win, qk_norm_g[3]), ((0, 0), (0, 0), (WINDOW, 0), (0, 0)))
    vw_pad = jnp.pad(v_win, ((0, 0), (0, 0), (WINDOW, 0), (0, 0)))
    n_q = S // Q_BLOCK
    q_chunks = q.reshape(B, G, R, n_q, Q_BLOCK, hd).transpose(3, 0, 1, 2, 4, 5)
    idx_chunks = sel_idx.reshape(B, G, n_q, Q_BLOCK, top_n).transpose(2, 0, 1, 3, 4)
    b_ix = jnp.arange(B)[:, None, None, None]
    g_ix = jnp.arange(G)[None, :, None, None]
    m_sel = top_n * SEL_LEN

    def block_fn(args):
        ci, qc, ic = args
        t = ci * Q_BLOCK + jnp.arange(Q_BLOCK)
        ks = ks_blocks[b_ix, g_ix, ic]
        vs = vs_blocks[b_ix, g_ix, ic]
        spos = ic[..., None] * SEL_LEN + jnp.arange(SEL_LEN)
        sd = (t[:, None, None] - spos).astype(jnp.float32)
        s = jnp.einsum('bgrqd,bgqnld->bgrqnl', qc, ks).astype(jnp.float32) \
            - slopes[None, :, :, None, None, None] * sd[:, :, None]
        smask = (sd >= 0)[:, :, None].reshape(B, G, 1, Q_BLOCK, m_sel)
        p = masked_softmax(s.reshape(B, G, R, Q_BLOCK, m_sel), smask)
        o_s = jnp.einsum('bgrqm,bgqmd->bgrqd', p.astype(vs.dtype), vs.reshape(B, G, Q_BLOCK, m_sel, hd))
        kw = lax.dynamic_slice_in_dim(kw_pad, ci * Q_BLOCK, Q_BLOCK + WINDOW, axis=2)
        vw = lax.dynamic_slice_in_dim(vw_pad, ci * Q_BLOCK, Q_BLOCK + WINDOW, axis=2)
        wpos = ci * Q_BLOCK - WINDOW + jnp.arange(Q_BLOCK + WINDOW)
        wd = t[:, None] - wpos[None, :]
        wmask = (wd >= 0) & (wd < WINDOW) & (wpos[None, :] >= 0)
        sw = jnp.einsum('bgrqd,bgmd->bgrqm', qc, kw).astype(jnp.float32) \
            - slopes[None, :, :, None, None] * wd.astype(jnp.float32)
        pw = masked_softmax(sw, wmask)
        o_w = jnp.einsum('bgrqm,bgmd->bgrqd', pw.astype(vw.dtype), vw)
        return o_s, o_w

    o_slc, o_win = lax.map(block_fn, (jnp.arange(n_q), q_chunks, idx_chunks))
    o_slc = o_slc.transpose(1, 2, 3, 0, 4, 5).reshape(B, G, R, S, hd)
    o_win = o_win.transpose(1, 2, 3, 0, 4, 5).reshape(B, G, R, S, hd)

    gates = jax.nn.sigmoid(gate_logits.astype(jnp.float32))
    gates = gates.reshape(B, S, G, R, N_NSA_BRANCH).transpose(0, 2, 3, 1, 4)
    o = gates[..., 0:1] * o_cmp + gates[..., 1:2] * o_slc + gates[..., 2:3] * o_win
    return o.transpose(0, 3, 1, 2, 4).reshape(B, S, NSA_WIDTH).astype(q.dtype)


def conv_mixer(u_glu, dw_w, dw_b, ln_g, ln_b):
    a, b = jnp.split(u_glu, 2, axis=-1)
    u = a * jax.nn.sigmoid(b)
    u = jnp.pad(u, ((0, 0), (CONV_TAPS - 1, 0), (0, 0)))
    y = lax.conv_general_dilated(u, dw_w[:, None, :], window_strides=(1,), padding='VALID',
                                 dimension_numbers=('NWC', 'WIO', 'NWC'),
                                 feature_group_count=CONV_WIDTH) + dw_b
    yf = y.astype(jnp.float32)
    mu = jnp.mean(yf, axis=-1, keepdims=True)
    var = jnp.mean(jnp.square(yf - mu), axis=-1, keepdims=True)
    yn = (yf - mu) * lax.rsqrt(var + NORM_EPS) * ln_g + ln_b
    return jax.nn.silu(yn).astype(u_glu.dtype)


def peer_ffn(h, w_q, sub_keys, u_tab, v_tab):
    B, S, D = h.shape
    T = B * S
    hf = h.reshape(T, D)
    q = (hf @ w_q).reshape(T, PEER_HEADS, 2, PEER_QDIM // 2)
    s = jnp.einsum('thcd,hcnd->thcn', q, sub_keys).astype(jnp.float32)
    s1, i1 = lax.top_k(s[:, :, 0], PEER_TOPK)
    s2, i2 = lax.top_k(s[:, :, 1], PEER_TOPK)
    cand = (s1[..., :, None] + s2[..., None, :]).reshape(T, PEER_HEADS, PEER_TOPK * PEER_TOPK)
    cand_idx = (i1[..., :, None] * PEER_NKEYS + i2[..., None, :]).reshape(T, PEER_HEADS, PEER_TOPK * PEER_TOPK)
    top_s, pos = lax.top_k(cand, PEER_TOPK)
    e_idx = jnp.take_along_axis(cand_idx, pos, axis=-1)
    gw = jax.nn.softmax(top_s, axis=-1).astype(h.dtype)
    n_blk = T // PEER_TOK_BLOCK

    def blk(args):
        hc, ec, gc = args
        ue = u_tab[ec]
        ve = v_tab[ec]
        act = jax.nn.gelu(jnp.einsum('td,thkd->thk', hc, ue), approximate=False)
        return jnp.einsum('thk,thkd->td', gc * act, ve)

    out = lax.map(blk, (hf.reshape(n_blk, PEER_TOK_BLOCK, D),
                        e_idx.reshape(n_blk, PEER_TOK_BLOCK, PEER_HEADS, PEER_TOPK),
                        gw.reshape(n_blk, PEER_TOK_BLOCK, PEER_HEADS, PEER_TOPK)))
    return out.reshape(B, S, D)


def setup_inputs(seed: int = 0) -> dict:
    key = jax.random.key(seed)
    ks = jax.random.split(key, 22)
    L = DEPTH

    def nrm(k, shape, scale):
        return jax.random.normal(k, shape, jnp.float32) * scale

    return {
        'x': nrm(ks[0], (BATCH, SEQ, D_MODEL), 1.0),
        'c': nrm(ks[1], (BATCH, D_MODEL), 1.0),
        'w_ada': nrm(ks[2], (L, D_MODEL, 6 * D_MODEL), 0.5 * D_MODEL ** -0.5),
        'b_ada': nrm(ks[3], (L, 6 * D_MODEL), 0.01),
        'norm_g': 1.0 + nrm(ks[4], (L, 2, D_MODEL), 0.02),
        'w_in': nrm(ks[5], (L, D_MODEL, IN_COLS), D_MODEL ** -0.5),
        'w_out': nrm(ks[6], (L, MIX_WIDTH, D_MODEL), MIX_WIDTH ** -0.5),
        'cmp_pe_k': nrm(ks[7], (L, CMP_LEN, HEAD_DIM), 0.1),
        'cmp_pe_v': nrm(ks[8], (L, CMP_LEN, HEAD_DIM), 0.1),
        'w_cmp_k': nrm(ks[9], (L, CMP_LEN, HEAD_DIM, HEAD_DIM), (CMP_LEN * HEAD_DIM) ** -0.5),
        'w_cmp_v': nrm(ks[10], (L, CMP_LEN, HEAD_DIM, HEAD_DIM), (CMP_LEN * HEAD_DIM) ** -0.5),
        'qk_norm_g': 1.0 + nrm(ks[11], (L, 4, HEAD_DIM), 0.02),
        'dw_w': nrm(ks[12], (L, CONV_TAPS, CONV_WIDTH), CONV_TAPS ** -0.5),
        'dw_b': nrm(ks[13], (L, CONV_WIDTH), 0.01),
        'conv_ln_g': 1.0 + nrm(ks[14], (L, CONV_WIDTH), 0.02),
        'conv_ln_b': nrm(ks[15], (L, CONV_WIDTH), 0.01),
        'peer_wq': nrm(ks[16], (L, D_MODEL, PEER_HEADS * PEER_QDIM), D_MODEL ** -0.5),
        'peer_sub_keys': nrm(ks[17], (L, PEER_HEADS, 2, PEER_NKEYS, PEER_QDIM // 2), (PEER_QDIM // 2) ** -0.5),
        'peer_u': nrm(ks[18], (L, PEER_EXPERTS, D_MODEL), D_MODEL ** -0.5),
        'peer_v': nrm(ks[19], (L, PEER_EXPERTS, D_MODEL), 0.5),
    }


def reference(x, c, w_ada, b_ada, norm_g, w_in, w_out, cmp_pe_k, cmp_pe_v, w_cmp_k, w_cmp_v,
              qk_norm_g, dw_w, dw_b, conv_ln_g, conv_ln_b, peer_wq, peer_sub_keys, peer_u, peer_v):
    B, S, _ = x.shape
    o_kv = N_Q_COLS
    o_gate = o_kv + N_KV_COLS
    o_glu = o_gate + N_GATE_COLS
    for l in range(DEPTH):
        mod = jax.nn.silu(c) @ w_ada[l] + b_ada[l]
        sh_m, sc_m, g_m, sh_f, sc_f, g_f = jnp.split(mod, 6, axis=-1)
        h = modulate(rmsnorm(x, norm_g[l, 0]), sh_m, sc_m)
        proj = h @ w_in[l]
        q = proj[..., :o_kv].reshape(B, S, NSA_HEADS, HEAD_DIM)
        kv = proj[..., o_kv:o_gate].reshape(B, S, 2 * N_NSA_BRANCH, NSA_KV_HEADS, HEAD_DIM)
        gl = proj[..., o_gate:o_glu].reshape(B, S, NSA_HEADS, N_NSA_BRANCH)
        glu = proj[..., o_glu:]
        a_out = nsa_mixer(q, kv, gl, cmp_pe_k[l], cmp_pe_v[l], w_cmp_k[l], w_cmp_v[l], qk_norm_g[l])
        c_out = conv_mixer(glu, dw_w[l], dw_b[l], conv_ln_g[l], conv_ln_b[l])
        mix = jnp.concatenate([a_out, c_out], axis=-1) @ w_out[l]
        x = x + g_m[:, None, :] * mix
        h = modulate(rmsnorm(x, norm_g[l, 1]), sh_f, sc_f)
        x = x + g_f[:, None, :] * peer_ffn(h, peer_wq[l], peer_sub_keys[l], peer_u[l], peer_v[l])
    return x
```

```cpp
#include <hip/hip_runtime.h>
#include <cstdio>
#include <cstdint>
namespace pg8 {
#define PG8_LAS __attribute__((address_space(3)))
typedef unsigned short bf16_t;
typedef short bf16x8 __attribute__((ext_vector_type(8)));
typedef float f32x4 __attribute__((ext_vector_type(4)));
typedef unsigned u32x4 __attribute__((ext_vector_type(4)));
constexpr int BM = 256, BK = 64, HALF = 128, HTB = HALF * BK * 2  , STAGE_BYTES = 8 * HTB, NXCD = 8, WGM = 8;

__host__ __device__ __forceinline__ int lds_byte(int r, int c) { const int st = (r >> 4) * 2 + (c >> 5), rr = r & 15, cc = c & 31, ob = rr * 64 + cc * 2; return st * 1024 + (ob ^ (((ob >> 9) & 1) << 5)); }
__host__ __device__ __forceinline__ void stage_rc(int b, int& R, int& C) { const int st = b / 1024, sb = b % 1024, swz = sb ^ (((sb >> 9) & 1) << 5); R = (st >> 1) * 16 + swz / 64; C = (st & 1) * 32 + (swz % 64) / 2; }
__host__ __device__ __forceinline__ int perm32(int rho) { const int n = rho >> 4, i = rho & 15; return 8 * (i >> 2) + 4 * n + (i & 3); }

struct Unit { int pm, pn; };
struct Gemm { const bf16_t* A; const bf16_t* Bt; int M, N, K; };

struct StaticOrder {
    int nM, nN, nwg, G, c;
    __host__ __device__ void init(int M, int N, int G_, int c_) { nM = M / BM; nN = N / BM; nwg = nM * nN; G = G_; c = c_; }
    __host__ __device__ bool next(int i, Unit& u) const {
        const long L = (long)i * G + c; if (L >= nwg) return false;
        int wgid = (int)L; { const int q = nwg / NXCD, r = nwg % NXCD, xcd = wgid % NXCD, off = wgid / NXCD; wgid = (xcd < r ? xcd * (q + 1) : r * (q + 1) + (xcd - r) * q) + off; }
        const int nig = WGM * nN, gid = wgid / nig, fm = gid * WGM, gsz = (nM - fm) < WGM ? (nM - fm) : WGM;
        u.pm = fm + ((wgid % nig) % gsz); u.pn = (wgid % nig) / gsz; return true;
    }
    __device__ __forceinline__ void a_ready(const Unit&) const {}
    __device__ __forceinline__ void done(const Unit&) const {}
};

__device__ __forceinline__ unsigned cvt_pk_bf16(float lo, float hi) { unsigned r; asm volatile("v_cvt_pk_bf16_f32 %0, %1, %2" : "=v"(r) : "v"(lo), "v"(hi)); return r; }
typedef float f32x2 __attribute__((ext_vector_type(2)));
__device__ __forceinline__ f32x2 gelu_pk(f32x2 v) {
    const f32x2 av = __builtin_elementwise_abs(v), d = av * 0.2316418882f + 1.0f;
    f32x2 t; t.x = __builtin_amdgcn_rcpf(d.x); t.y = __builtin_amdgcn_rcpf(d.y);
    f32x2 q = t * 0.5307027145f + (-0.7265760135f); q = q * t + 0.7107068705f; q = q * t + (-0.142248368f); q = q * t + 0.127414796f; q = q * t;
    const f32x2 s = (v * v) * (-0.72134752044f);
    f32x2 e; e.x = __builtin_amdgcn_exp2f(s.x); e.y = __builtin_amdgcn_exp2f(s.y);
    const f32x2 m = v * (q * e), r = v - m;
    f32x2 o; o.x = v.x < 0.f ? m.x : r.x; o.y = v.y < 0.f ? m.y : r.y; return o;
}

template <int ACT  > struct EpiBf16 {
    static constexpr bool PERM = true, AFTER_DRAIN = false; static_assert(ACT == 0 || ACT == 1, "EpiBf16: ACT is 0 (none) or 1 (gelu_pk)");
    bf16_t* O; int ldc; const float* bias; int split_cols; size_t split_stride; float scale0;
    __device__ __forceinline__ void operator()(const f32x4 (&acc)[2][2][4][2], const Unit& u, int wr, int wc, int fr, int fq) const {
        const int row0 = u.pm * BM + wr * 64 + fr; int colt = u.pn * BM; bf16_t* base = O;
        float sc = 1.f; if (split_cols) { const int t = colt / split_cols; base += (size_t)t * split_stride; colt -= t * split_cols; if (t == 0) sc = scale0; }
        const int col0 = colt + wc * 32 + 8 * fq, bcol0 = u.pn * BM + wc * 32 + 8 * fq;
        f32x4 bv[2][2];
#pragma unroll
        for (int bj = 0; bj < 2; ++bj)
#pragma unroll
            for (int n = 0; n < 2; ++n) bv[bj][n] = bias ? *(const f32x4*)(bias + bcol0 + bj * HALF + 4 * n) : (f32x4){0.f, 0.f, 0.f, 0.f};
#pragma unroll
        for (int ai = 0; ai < 2; ++ai)
#pragma unroll
            for (int m = 0; m < 4; ++m) { bf16_t* rowp = base + (size_t)(row0 + ai * HALF + m * 16) * ldc + col0;
#pragma unroll
                for (int bj = 0; bj < 2; ++bj) { f32x4 v0 = acc[ai][bj][m][0] + bv[bj][0], v1 = acc[ai][bj][m][1] + bv[bj][1];
                    if (ACT == 1) { f32x2 a = gelu_pk((f32x2){v0[0], v0[1]}), b = gelu_pk((f32x2){v0[2], v0[3]}), c = gelu_pk((f32x2){v1[0], v1[1]}), d = gelu_pk((f32x2){v1[2], v1[3]});
                        v0 = (f32x4){a.x, a.y, b.x, b.y}; v1 = (f32x4){c.x, c.y, d.x, d.y}; }
                    v0 = v0 * sc; v1 = v1 * sc; u32x4 w; w.x = cvt_pk_bf16(v0[0], v0[1]); w.y = cvt_pk_bf16(v0[2], v0[3]); w.z = cvt_pk_bf16(v1[0], v1[1]); w.w = cvt_pk_bf16(v1[2], v1[3]);
                    *(u32x4*)(rowp + bj * HALF) = w; } }
    }
};
struct EpiResGate {
    static constexpr bool PERM = false, AFTER_DRAIN = false;
    const float* base; float* out; int ldc; const float* gate; int gate_ld; int rows_per_batch;
    __device__ __forceinline__ void operator()(const f32x4 (&acc)[2][2][4][2], const Unit& u, int wr, int wc, int fr, int fq) const {
        const int col0 = u.pn * BM + wc * 32 + 4 * fq;
        const int b = (u.pm * BM) / rows_per_batch;
        f32x4 gv[2][2];
#pragma unroll
        for (int bj = 0; bj < 2; ++bj)
#pragma unroll
            for (int n = 0; n < 2; ++n) gv[bj][n] = *(const f32x4*)(gate + (size_t)b * gate_ld + col0 + bj * HALF + n * 16);
#pragma unroll
        for (int ai = 0; ai < 2; ++ai)
#pragma unroll
            for (int m = 0; m < 4; ++m) { const size_t off = (size_t)(u.pm * BM + ai * HALF + wr * 64 + m * 16 + fr) * ldc + col0;
#pragma unroll
                for (int bj = 0; bj < 2; ++bj)
#pragma unroll
                    for (int n = 0; n < 2; ++n) { const f32x4 bs = *(const f32x4*)(base + off + bj * HALF + n * 16);
                        *(f32x4*)(out + off + bj * HALF + n * 16) = bs + gv[bj][n] * acc[ai][bj][m][n]; } }
    }
};
template <class Epi, class Sched, bool ALIGN_EPI = false, bool SP2 = false>
__device__ __forceinline__ void gemm_phase(PG8_LAS unsigned char* lds, const Gemm g, const Sched& S, const Epi& E) {
    const int tid = threadIdx.x, wid = __builtin_amdgcn_readfirstlane(tid >> 6), lane = tid & 63, wr = wid >> 2, wc = wid & 3, fr = lane & 15, fq = lane >> 4;
    const int K = g.K, nt = K / BK;
    unsigned voffA[2], voffB[2];
#pragma unroll
    for (int i = 0; i < 2; ++i) { int R, C; stage_rc(tid * 16 + i * 8192, R, C); const int Rb = Epi::PERM ? ((R & ~31) + perm32(R & 31)) : R;
        voffA[i] = (unsigned)(R * K + C) * 2u; voffB[i] = (unsigned)(Rb * K + C) * 2u; }
    const size_t kstep = (size_t)(BK * 2);
    const size_t hstep = (size_t)HALF * K * 2;
    const size_t tstep = 2 * hstep;
    const unsigned ldsw = (unsigned)wid * 1024u;
    const int aoff = lds_byte(wr * 64 + fr, fq * 8), boff = lds_byte(wc * 32 + fr, fq * 8);
#define PG8_SA(b, h) (((b) * 2 + (h)) * HTB)
#define PG8_SB(b, h) ((4 + (b) * 2 + (h)) * HTB)
#define PG8_STAGE(bufoff, gbase, voff) do { _Pragma("unroll") for (int _i = 0; _i < 2; ++_i) \
        __builtin_amdgcn_global_load_lds((const unsigned*)((const char*)(gbase) + (voff)[_i]), (PG8_LAS unsigned*)(lds + (bufoff) + ldsw + _i * 8192), 16, 0, 0); } while (0)
#define PG8_LDA(dst, b, h) do { _Pragma("unroll") for (int m = 0; m < 4; ++m) _Pragma("unroll") for (int k = 0; k < 2; ++k) dst[m][k] = *(const PG8_LAS bf16x8*)(lds + PG8_SA(b, h) + aoff + m * 2048 + k * 1024); } while (0)
#define PG8_LDB(dst, b, h) do { _Pragma("unroll") for (int n = 0; n < 2; ++n) _Pragma("unroll") for (int k = 0; k < 2; ++k) dst[n][k] = *(const PG8_LAS bf16x8*)(lds + PG8_SB(b, h) + boff + n * 2048 + k * 1024); } while (0)
#define PG8_MMA(ai, bj, At, Bt) do { __builtin_amdgcn_s_setprio(1); _Pragma("unroll") for (int m = 0; m < 4; ++m) _Pragma("unroll") for (int n = 0; n < 2; ++n) _Pragma("unroll") for (int k = 0; k < 2; ++k) \
        acc[ai][bj][m][n] = __builtin_amdgcn_mfma_f32_16x16x32_bf16(Bt[n][k], At[m][k], acc[ai][bj][m][n], 0, 0, 0); __builtin_amdgcn_s_setprio(0); } while (0)
#define PG8_WAIT_V(n) asm volatile("s_waitcnt vmcnt(" #n ")" ::: "memory")
#define PG8_WAIT_L(n) asm volatile("s_waitcnt lgkmcnt(" #n ")" ::: "memory")
#define PG8_BAR __builtin_amdgcn_s_barrier()
#define PG8_SCHED __builtin_amdgcn_sched_barrier(0)
    Unit cur, nxt; int ui = 0;
    if (!S.next(0, cur)) return;
    f32x4 acc[2][2][4][2];
#pragma unroll
    for (int a = 0; a < 2; ++a)
#pragma unroll
        for (int b = 0; b < 2; ++b)
#pragma unroll
            for (int m = 0; m < 4; ++m)
#pragma unroll
                for (int n = 0; n < 2; ++n) acc[a][b][m][n] = (f32x4){0.f, 0.f, 0.f, 0.f};
    bf16x8 At[4][2], B0[2][2], B1[2][2];
    const char* cA = (const char*)g.A + (size_t)cur.pm * tstep; const char* cB = (const char*)g.Bt + (size_t)cur.pn * tstep;
    S.a_ready(cur);
    if constexpr (SP2) {
        PG8_STAGE(PG8_SB(0, 0), cB, voffB); PG8_STAGE(PG8_SB(0, 1), cB + hstep, voffB); PG8_STAGE(PG8_SA(0, 0), cA, voffA); PG8_STAGE(PG8_SA(0, 1), cA + hstep, voffA);
        if (wr == 1) PG8_BAR;
        PG8_WAIT_V(2); PG8_BAR;
        PG8_STAGE(PG8_SB(1, 0), cB + kstep, voffB); PG8_STAGE(PG8_SA(1, 0), cA + kstep, voffA); PG8_STAGE(PG8_SB(1, 1), cB + hstep + kstep, voffB);
        PG8_WAIT_V(6); PG8_BAR;
    } else {
        PG8_STAGE(PG8_SB(0, 0), cB, voffB); PG8_STAGE(PG8_SA(0, 0), cA, voffA); PG8_STAGE(PG8_SB(0, 1), cB + hstep, voffB); PG8_STAGE(PG8_SA(0, 1), cA + hstep, voffA);
        if (wr == 1) PG8_BAR;
        PG8_WAIT_V(4); PG8_BAR;
        PG8_STAGE(PG8_SB(1, 0), cB + kstep, voffB); PG8_STAGE(PG8_SA(1, 0), cA + kstep, voffA); PG8_STAGE(PG8_SB(1, 1), cB + hstep + kstep, voffB);
        PG8_WAIT_V(6); PG8_BAR;
    }
    for (;;) {
        const bool has_next = S.next(ui + 1, nxt);
        const char* nA = has_next ? (const char*)g.A + (size_t)nxt.pm * tstep : cA; const char* nB = has_next ? (const char*)g.Bt + (size_t)nxt.pn * tstep : cB;
        for (int t = 0; t < nt; t += 2) {
            const bool last = (t == nt - 2);
            const char* a1 = cA + (size_t)(t + 1) * kstep;
            const char* a2 = last ? nA : cA + (size_t)(t + 2) * kstep; const char* b2 = last ? nB : cB + (size_t)(t + 2) * kstep;
            const char* a3 = a2 + kstep; const char* b3 = b2 + kstep;
            if (last && has_next) S.a_ready(nxt);
            if constexpr (SP2) {
            PG8_LDB(B0, 0, 0); PG8_LDB(B1, 0, 1); PG8_SCHED; PG8_LDA(At, 0, 0); PG8_STAGE(PG8_SA(1, 1), a1 + hstep, voffA);
            PG8_WAIT_V(8); PG8_WAIT_L(0); PG8_BAR; PG8_MMA(0, 0, At, B0); PG8_MMA(0, 1, At, B1); PG8_BAR; PG8_SCHED;
            PG8_LDA(At, 0, 1); PG8_STAGE(PG8_SB(0, 0), b2, voffB); PG8_STAGE(PG8_SB(0, 1), b2 + hstep, voffB); PG8_STAGE(PG8_SA(0, 0), a2, voffA);
            PG8_WAIT_V(8); PG8_WAIT_L(0); PG8_BAR; PG8_MMA(1, 0, At, B0); PG8_MMA(1, 1, At, B1); PG8_BAR; PG8_SCHED;
            PG8_LDB(B0, 1, 0); PG8_LDB(B1, 1, 1); PG8_SCHED; PG8_LDA(At, 1, 0); PG8_STAGE(PG8_SA(0, 1), a2 + hstep, voffA);
            PG8_WAIT_V(8); PG8_WAIT_L(0); PG8_BAR; PG8_MMA(0, 0, At, B0); PG8_MMA(0, 1, At, B1); PG8_BAR; PG8_SCHED;
            PG8_LDA(At, 1, 1); PG8_STAGE(PG8_SB(1, 0), b3, voffB); PG8_STAGE(PG8_SB(1, 1), b3 + hstep, voffB); PG8_STAGE(PG8_SA(1, 0), a3, voffA);
            PG8_WAIT_V(8); PG8_WAIT_L(0); PG8_BAR; PG8_MMA(1, 0, At, B0); PG8_MMA(1, 1, At, B1); PG8_BAR; PG8_SCHED;
            } else {
            PG8_LDB(B0, 0, 0); PG8_SCHED; PG8_LDA(At, 0, 0); PG8_STAGE(PG8_SA(1, 1), a1 + hstep, voffA);
            PG8_WAIT_L(8); PG8_BAR; PG8_WAIT_L(0); PG8_MMA(0, 0, At, B0); PG8_BAR; PG8_SCHED;
            PG8_LDB(B1, 0, 1); PG8_STAGE(PG8_SB(0, 0), b2, voffB);
            PG8_BAR; PG8_WAIT_L(0); PG8_MMA(0, 1, At, B1); PG8_BAR;
            PG8_LDA(At, 0, 1); PG8_STAGE(PG8_SA(0, 0), a2, voffA);
            PG8_BAR; PG8_WAIT_L(0); PG8_MMA(1, 0, At, B0); PG8_BAR; PG8_SCHED;
            PG8_STAGE(PG8_SB(0, 1), b2 + hstep, voffB);
            PG8_WAIT_V(6); PG8_BAR; PG8_MMA(1, 1, At, B1); PG8_BAR;
            PG8_LDB(B0, 1, 0); PG8_SCHED; PG8_LDA(At, 1, 0); PG8_STAGE(PG8_SA(0, 1), a2 + hstep, voffA);
            PG8_WAIT_L(8); PG8_BAR; PG8_WAIT_L(0); PG8_MMA(0, 0, At, B0); PG8_BAR; PG8_SCHED;
            PG8_LDB(B1, 1, 1); PG8_STAGE(PG8_SB(1, 0), b3, voffB);
            PG8_BAR; PG8_WAIT_L(0); PG8_MMA(0, 1, At, B1); PG8_BAR;
            PG8_LDA(At, 1, 1); PG8_STAGE(PG8_SA(1, 0), a3, voffA);
            PG8_BAR; PG8_WAIT_L(0); PG8_MMA(1, 0, At, B0); PG8_BAR; PG8_SCHED;
            PG8_STAGE(PG8_SB(1, 1), b3 + hstep, voffB);
            PG8_WAIT_V(6); PG8_BAR; PG8_MMA(1, 1, At, B1); PG8_BAR;
            }
        }
        if constexpr (ALIGN_EPI) { if (wr == 0) PG8_BAR; }
        if constexpr (!Epi::AFTER_DRAIN) { E(acc, cur, wr, wc, fr, fq); S.done(cur); }
        if (!has_next) break;
#pragma unroll
        for (int a = 0; a < 2; ++a)
#pragma unroll
            for (int b = 0; b < 2; ++b)
#pragma unroll
                for (int m = 0; m < 4; ++m)
#pragma unroll
                    for (int n = 0; n < 2; ++n) acc[a][b][m][n] = (f32x4){0.f, 0.f, 0.f, 0.f};
        cur = nxt; cA = nA; cB = nB; ++ui;
        if constexpr (ALIGN_EPI) { if (wr == 1) PG8_BAR; }
    }
    PG8_WAIT_V(0);
    if constexpr (!ALIGN_EPI) { if (wr == 0) PG8_BAR; }
    PG8_BAR;
    if constexpr (Epi::AFTER_DRAIN) { E.fused(acc, cur, wr, wc, fr, fq, lds, wid, lane); S.done(cur); }
#undef PG8_SA
#undef PG8_SB
#undef PG8_STAGE
#undef PG8_LDA
#undef PG8_LDB
#undef PG8_MMA
#undef PG8_WAIT_V
#undef PG8_WAIT_L
#undef PG8_BAR
#undef PG8_SCHED
}
}

#define LAS __attribute__((address_space(3)))
typedef unsigned short bf16;
typedef unsigned v4u __attribute__((ext_vector_type(4)));
typedef unsigned v2u __attribute__((ext_vector_type(2)));
typedef int v4i __attribute__((ext_vector_type(4)));
typedef int v2i __attribute__((ext_vector_type(2)));
typedef float f32x4 __attribute__((ext_vector_type(4)));
typedef float f32x2 __attribute__((ext_vector_type(2)));
typedef float f32x16 __attribute__((ext_vector_type(16)));
typedef short bf16x8 __attribute__((ext_vector_type(8)));
typedef short s16x4 __attribute__((ext_vector_type(4)));
typedef __bf16 bf16x2_t __attribute__((ext_vector_type(2)));

constexpr int NWAVES = 8, NTHR = 512;
constexpr int BATCH = 8, SEQ = 2048, DM = 1024, TOK = BATCH * SEQ;
constexpr int NPROJ = 2560, C_KV = 512, C_GLU = 1280, C_GATE = 2304, IN_COLS = 2328;
constexpr int NQP = 2048, NMOD = 6144;
constexpr float EPS = 1e-6f, LOG2E = 1.4426950408889634f;
constexpr int LDS_BYTES = 162816, LDS_CTL_OFF = 161792, PG_WSTRIDE = 20224;

constexpr size_t MiB = 1u << 20;
constexpr size_t WS_MODP = 0, WS_MOD = 3 * MiB, WS_BIASP = 3 * MiB + 256 * 1024, WS_SUBK = 3 * MiB + 512 * 1024;
constexpr size_t WS_WCK = 4 * MiB, WS_WCV = 4 * MiB + 256 * 1024, WS_KC = 4 * MiB + 512 * 1024, WS_VC = 4 * MiB + 768 * 1024;
constexpr size_t WS_WIN = 5 * MiB, WS_WOUT = 10 * MiB, WS_WQ = 12 * MiB;
constexpr size_t WS_KS = 16 * MiB, WS_VS = 20 * MiB, WS_KW = 24 * MiB, WS_VW = 28 * MiB;
constexpr size_t WS_ENTG = 16 * MiB;
constexpr size_t WS_H = 32 * MiB, WS_MIX = 64 * MiB, WS_PROJ = 96 * MiB, WS_QP = 96 * MiB;
constexpr size_t WS_U8 = 176 * MiB, WS_V8 = 192 * MiB, WS_SU = 208 * MiB, WS_SV = 208 * MiB + 65536, WS_SH = 208 * MiB + 131072, WS_H8 = 224 * MiB, WS_END = 240 * MiB;
constexpr size_t WS_META = 64 * MiB, META_STRIDE = 12288;

struct Args {
    const float *x, *c, *w_ada, *b_ada, *norm_g, *w_in, *w_out, *pe_k, *pe_v, *w_ck, *w_cv, *qkg, *dw_w, *dw_b, *ln_g, *ln_b, *wq, *subk, *pu, *pv;
    float* out; unsigned char* ws;
};

__device__ __forceinline__ float bf2f(unsigned short v) { return __uint_as_float((unsigned)v << 16); }
__device__ __forceinline__ float bflo(unsigned v) { return __uint_as_float(v << 16); }
__device__ __forceinline__ float bfhi(unsigned v) { return __uint_as_float(v & 0xffff0000u); }
__device__ __forceinline__ unsigned cvtpk(float lo, float hi) { f32x2 v = {lo, hi}; bf16x2_t b = __builtin_convertvector(v, bf16x2_t); return __builtin_bit_cast(unsigned, b); }
__device__ __forceinline__ float wave_sum(float v) {
#pragma unroll
    for (int o = 1; o < 64; o <<= 1) v += __shfl_xor(v, o);
    return v;
}
__device__ __forceinline__ float swap32(float v) { return __shfl_xor(v, 32); }
__device__ __forceinline__ float pairmax32(float v) { const auto rr = __builtin_amdgcn_permlane32_swap(__float_as_uint(v), __float_as_uint(v), false, false); return fmaxf(__uint_as_float(rr[0]), __uint_as_float(rr[1])); }
__device__ __forceinline__ float pairsum32(float v) { const auto rr = __builtin_amdgcn_permlane32_swap(__float_as_uint(v), __float_as_uint(v), false, false); return __uint_as_float(rr[0]) + __uint_as_float(rr[1]); }
__device__ __forceinline__ int crow(int r, int hi) { return (r & 3) + 8 * (r >> 2) + 4 * hi; }
__device__ __forceinline__ f32x16 mfma32(bf16x8 a, bf16x8 b, f32x16 c) { return __builtin_amdgcn_mfma_f32_32x32x16_bf16(a, b, c, 0, 0, 0); }
__device__ __forceinline__ float fast_exp2(float x) { return __builtin_amdgcn_exp2f(x); }
__device__ __forceinline__ float sigmoidf_(float x) { return __builtin_amdgcn_rcpf(1.0f + __expf(-x)); }

__device__ __forceinline__ void transpose_item(const float* W, int ldw, int col0, int ncols, bf16* WT, int K, int drow0, int k0, LAS float* scr, int lane) {
    const int n = lane & 31;
#pragma unroll 16
    for (int i = 0; i < 32; ++i) { const int kk = 2 * i + (lane >> 5); scr[kk * 33 + n] = (n < ncols) ? W[(size_t)(k0 + kk) * ldw + col0 + n] : 0.f; }
    asm volatile("s_waitcnt lgkmcnt(0)" ::: "memory");
    const int c = lane & 7;
#pragma unroll
    for (int j = 0; j < 4; ++j) { const int nn = (lane >> 3) + 8 * j; const LAS float* s = scr + (8 * c) * 33 + nn;
        v4u o; o.x = cvtpk(s[0 * 33], s[1 * 33]); o.y = cvtpk(s[2 * 33], s[3 * 33]); o.z = cvtpk(s[4 * 33], s[5 * 33]); o.w = cvtpk(s[6 * 33], s[7 * 33]);
        *(v4u*)(WT + (size_t)(drow0 + nn) * K + k0 + 8 * c) = o; }
    asm volatile("s_waitcnt lgkmcnt(0)" ::: "memory");
}

__device__ __forceinline__ void tab_convert_item(const Args& A, int it, int lane) {
    unsigned char* ws = A.ws;
            const int which = it >> 11, r0 = (it & 2047) * 8;
    for (int rb = 0; rb < 8; rb += 4) {
        f32x4 v[4][4]; float am[4];
#pragma unroll
        for (int rr = 0; rr < 4; ++rr) { const float* src = (which ? A.pv : A.pu) + (size_t)(r0 + rb + rr) * DM + 4 * lane;
#pragma unroll
            for (int j = 0; j < 4; ++j) v[rr][j] = *(const f32x4*)(src + 256 * j); }
#pragma unroll
        for (int rr = 0; rr < 4; ++rr) { float m_ = 0.f;
#pragma unroll
            for (int j = 0; j < 4; ++j) m_ = fmaxf(fmaxf(m_, fmaxf(fabsf(v[rr][j][0]), fabsf(v[rr][j][1]))), fmaxf(fabsf(v[rr][j][2]), fabsf(v[rr][j][3])));
            am[rr] = m_; }
#pragma unroll
        for (int o = 1; o < 64; o <<= 1) {
#pragma unroll
            for (int rr = 0; rr < 4; ++rr) am[rr] = fmaxf(am[rr], __shfl_xor(am[rr], o)); }
#pragma unroll
        for (int rr = 0; rr < 4; ++rr) { const int rowi = r0 + rb + rr; const float sc = am[rr] > 0.f ? am[rr] * (which ? (1.0f / 240.0f) : (1.0f / 127.0f)) : 1.0f, isc = 1.0f / sc;
#pragma unroll
            for (int j = 0; j < 4; ++j) { unsigned w = 0u;
                if (which) { int p = __builtin_amdgcn_cvt_pk_fp8_f32(v[rr][j][0] * isc, v[rr][j][1] * isc, 0, false); p = __builtin_amdgcn_cvt_pk_fp8_f32(v[rr][j][2] * isc, v[rr][j][3] * isc, p, true); w = (unsigned)p; }
                else {
#pragma unroll
                    for (int i = 0; i < 4; ++i) { const int q = (int)rintf(v[rr][j][i] * isc); w |= ((unsigned)q & 0xFFu) << (8 * i); } }
                *(unsigned*)(ws + (which ? WS_V8 : WS_U8) + (size_t)rowi * DM + 256 * j + 4 * lane) = w; }
            if (lane == 0) ((float*)(ws + (which ? WS_SV : WS_SU)))[rowi] = sc; } }
}

__device__ __forceinline__ void p0_prologue(const Args& A, LAS unsigned char* lds, int gw, int NGW, int tid, int lane, int wave) {
    unsigned char* ws = A.ws;
    LAS float* SILU = (LAS float*)(lds + 73728);
    for (int i = tid; i < BATCH * DM; i += NTHR) { const float v = A.c[i]; SILU[i] = v / (1.0f + __expf(-v)); }
    __syncthreads();
    LAS float* scr = (LAS float*)(lds + wave * 8704);
    constexpr int NI_MODP = 192 * 16, NI_T1 = 640, NI_T2 = 512, NI_T3 = 16, NI_TO = 512, NI_TQ = 1024, NI_TCK = 64, NI_TCV = 64, NI_ZP = 28, NI_SK = 128, NI_BP = 64;
    constexpr int NIT = NI_MODP + NI_T1 + NI_T2 + NI_T3 + NI_TO + NI_TQ + NI_TCK + NI_TCV + NI_ZP + NI_SK + NI_BP;
    for (int it0 = gw; it0 < NIT; it0 += NGW) {
        int it = it0;
        if (it < NI_MODP) {
            const int cb = it % 192, ks = it / 192, col = cb * 32 + (lane & 31), kpar = lane >> 5;
            float acc[8];
#pragma unroll
            for (int b = 0; b < 8; ++b) acc[b] = 0.f;
#pragma unroll 16
            for (int i = 0; i < 32; ++i) { const int k = ks * 64 + 2 * i + kpar; const float w = A.w_ada[(size_t)k * NMOD + col];
#pragma unroll
                for (int b = 0; b < 8; ++b) acc[b] += SILU[b * DM + k] * w; }
            float* MODP = (float*)(ws + WS_MODP);
#pragma unroll
            for (int b = 0; b < 8; ++b) { const float s = acc[b] + __shfl_xor(acc[b], 32); if (lane < 32) MODP[(size_t)(ks * 8 + b) * NMOD + col] = s; }
            continue;
        } it -= NI_MODP;
        if (it < NI_T1) { transpose_item(A.w_in, IN_COLS, (it % 40) * 32, 32, (bf16*)(ws + WS_WIN), DM, (it % 40) * 32, (it / 40) * 64, scr, lane); continue; } it -= NI_T1;
        if (it < NI_T2) { transpose_item(A.w_in, IN_COLS, 1304 + (it % 32) * 32, 32, (bf16*)(ws + WS_WIN), DM, C_GLU + (it % 32) * 32, (it / 32) * 64, scr, lane); continue; } it -= NI_T2;
        if (it < NI_T3) { transpose_item(A.w_in, IN_COLS, 1280, 24, (bf16*)(ws + WS_WIN), DM, C_GATE, it * 64, scr, lane); continue; } it -= NI_T3;
        if (it < NI_TO) { transpose_item(A.w_out, DM, (it % 32) * 32, 32, (bf16*)(ws + WS_WOUT), DM, (it % 32) * 32, (it / 32) * 64, scr, lane); continue; } it -= NI_TO;
        if (it < NI_TQ) { transpose_item(A.wq, NQP, (it % 64) * 32, 32, (bf16*)(ws + WS_WQ), DM, (it % 64) * 32, (it / 64) * 64, scr, lane); continue; } it -= NI_TQ;
        if (it < NI_TCK) { transpose_item(A.w_ck, 64, (it & 1) * 32, 32, (bf16*)(ws + WS_WCK), 2048, (it & 1) * 32, (it >> 1) * 64, scr, lane); continue; } it -= NI_TCK;
        if (it < NI_TCV) { transpose_item(A.w_cv, 64, (it & 1) * 32, 32, (bf16*)(ws + WS_WCV), 2048, (it & 1) * 32, (it >> 1) * 64, scr, lane); continue; } it -= NI_TCV;
        if (it < NI_ZP) { bf16* base = (bf16*)(ws + WS_WIN) + (size_t)(2336 + it * 8) * DM;
#pragma unroll 4
            for (int i = 0; i < 16; ++i) *(v4u*)(base + i * 512 + lane * 8) = (v4u){0u, 0u, 0u, 0u};
            continue; } it -= NI_ZP;
        if (it < NI_SK) { const float* src = A.subk + (size_t)it * 2048; bf16* dst = (bf16*)(ws + WS_SUBK) + (size_t)it * 2048;
#pragma unroll
            for (int i = 0; i < 4; ++i) { const f32x4 a = *(const f32x4*)(src + i * 512 + lane * 8), b = *(const f32x4*)(src + i * 512 + lane * 8 + 4);
                v4u o; o.x = cvtpk(a[0], a[1]); o.y = cvtpk(a[2], a[3]); o.z = cvtpk(b[0], b[1]); o.w = cvtpk(b[2], b[3]); *(v4u*)(dst + i * 512 + lane * 8) = o; }
            continue; } it -= NI_SK;
        { const int kv = it >> 5, l = it & 31; const float* pe = (kv ? A.pe_v : A.pe_k) + l * 64; const float* w = (kv ? A.w_cv : A.w_ck) + (size_t)l * 64 * 64;
            float s = 0.f;
#pragma unroll 32
            for (int d = 0; d < 64; ++d) s += pe[d] * w[d * 64 + lane];
            ((float*)(ws + WS_BIASP))[(kv * 32 + l) * 64 + lane] = s; }
    }
}

template <bool FROM_PARTIALS, bool Q8>
__device__ __forceinline__ void norm_mod(const Args& A, const float* X, const float* gvec, int sh_off, int sc_off, bf16* Hout, int blk, int wave, int lane) {
    const float* MODP = (const float*)(A.ws + WS_MODP); const float* MODF = (const float*)(A.ws + WS_MOD);
    for (int rb = blk; rb < TOK / 64; rb += gridDim.x) {
        const int b = rb >> 5;
        f32x4 ca[4], cb[4];
#pragma unroll
        for (int j = 0; j < 4; ++j) { const int col = 256 * j + 4 * lane; f32x4 sc, sh;
            if (FROM_PARTIALS) { sc = *(const f32x4*)(A.b_ada + sc_off + col); sh = *(const f32x4*)(A.b_ada + sh_off + col);
                for (int ks = 0; ks < 16; ++ks) { sc += *(const f32x4*)(MODP + (size_t)(ks * 8 + b) * NMOD + sc_off + col); sh += *(const f32x4*)(MODP + (size_t)(ks * 8 + b) * NMOD + sh_off + col); } }
            else { sc = *(const f32x4*)(MODF + b * NMOD + sc_off + col); sh = *(const f32x4*)(MODF + b * NMOD + sh_off + col); }
            const f32x4 g = *(const f32x4*)(gvec + col); ca[j] = g * (sc + 1.0f); cb[j] = sh; }
        for (int rr = 0; rr < 8; ++rr) { const int row = rb * 64 + wave * 8 + rr; const float* xr = X + (size_t)row * DM + 4 * lane;
            f32x4 v[4]; float ss = 0.f;
#pragma unroll
            for (int j = 0; j < 4; ++j) { v[j] = *(const f32x4*)(xr + 256 * j); ss += (v[j][0] * v[j][0] + v[j][1] * v[j][1]) + (v[j][2] * v[j][2] + v[j][3] * v[j][3]); }
            const float rstd = rsqrtf(wave_sum(ss) * (1.0f / DM) + EPS);
#pragma unroll
            for (int j = 0; j < 4; ++j) { const f32x4 o = v[j] * rstd * ca[j] + cb[j]; v[j] = o; v2u w; w.x = cvtpk(o[0], o[1]); w.y = cvtpk(o[2], o[3]); *(v2u*)(Hout + (size_t)row * DM + 256 * j + 4 * lane) = w; }
            if (Q8) { float am = 0.f;
#pragma unroll
                for (int j = 0; j < 4; ++j) am = fmaxf(fmaxf(am, fmaxf(fabsf(v[j][0]), fabsf(v[j][1]))), fmaxf(fabsf(v[j][2]), fabsf(v[j][3])));
#pragma unroll
                for (int o = 1; o < 64; o <<= 1) am = fmaxf(am, __shfl_xor(am, o));
                const float sc = am > 0.f ? am * (1.0f / 127.0f) : 1.0f, isc = 1.0f / sc;
#pragma unroll
                for (int j = 0; j < 4; ++j) { unsigned w = 0u;
#pragma unroll
                    for (int i = 0; i < 4; ++i) w |= ((unsigned)((int)rintf(v[j][i] * isc)) & 0xFFu) << (8 * i);
                    *(unsigned*)(A.ws + WS_H8 + (size_t)row * DM + 256 * j + 4 * lane) = w; }
                if (lane == 0) ((float*)(A.ws + WS_SH))[row] = sc; } }
    }
}
__device__ __forceinline__ void mod_final(const Args& A, int blk, int tid) {
    const float* MODP = (const float*)(A.ws + WS_MODP); float* MODF = (float*)(A.ws + WS_MOD);
    for (int idx = blk * NTHR + tid; idx < BATCH * NMOD; idx += gridDim.x * NTHR) { const int b = idx / NMOD, n = idx % NMOD; float s = A.b_ada[n];
        for (int ks = 0; ks < 16; ++ks) s += MODP[(size_t)(ks * 8 + b) * NMOD + n];
        MODF[idx] = s; }
}

__device__ __forceinline__ void knorm_item(const Args& A, int item, int wave, int lane) {
    const bf16* PROJ = (const bf16*)(A.ws + WS_PROJ);
    const int rowid = lane >> 3, chunk = lane & 7, kind = rowid >> 1, g = rowid & 1;
    bf16* dstb = (bf16*)(A.ws + (kind == 0 ? WS_KS : kind == 1 ? WS_VS : kind == 2 ? WS_KW : WS_VW));
    float gk[8];
#pragma unroll
    for (int i = 0; i < 8; ++i) gk[i] = A.qkg[(kind == 0 ? 128 : 192) + chunk * 8 + i];
    for (int rr = 0; rr < 8; ++rr) { const int tok = item * 64 + wave * 8 + rr, b = tok >> 11, s = tok & 2047;
        const v4u raw = *(const v4u*)(PROJ + (size_t)tok * NPROJ + 768 + rowid * 64 + chunk * 8);
        float v[8]; v[0] = bflo(raw.x); v[1] = bfhi(raw.x); v[2] = bflo(raw.y); v[3] = bfhi(raw.y); v[4] = bflo(raw.z); v[5] = bfhi(raw.z); v[6] = bflo(raw.w); v[7] = bfhi(raw.w);
        float ss = 0.f;
#pragma unroll
        for (int i = 0; i < 8; ++i) ss += v[i] * v[i];
        ss += __shfl_xor(ss, 1); ss += __shfl_xor(ss, 2); ss += __shfl_xor(ss, 4);
        v4u o = raw;
        if ((kind & 1) == 0) { const float rstd = rsqrtf(ss * (1.0f / 64.0f) + EPS);
#pragma unroll
            for (int i = 0; i < 8; ++i) v[i] = v[i] * rstd * gk[i];
            o.x = cvtpk(v[0], v[1]); o.y = cvtpk(v[2], v[3]); o.z = cvtpk(v[4], v[5]); o.w = cvtpk(v[6], v[7]); }
        *(v4u*)(dstb + ((size_t)(b * 2 + g) * SEQ + s) * 64 + chunk * 8) = o; }
}

__device__ __forceinline__ void cmp_unit(const Args& A, LAS unsigned char* lds, int u, int tid, int wave, int lane) {
    const bf16* PROJ = (const bf16*)(A.ws + WS_PROJ);
    const int b = u >> 4, g = (u >> 3) & 1, kv = (u >> 2) & 1, nq4 = u & 3;
    const int r32 = lane & 31, hi = lane >> 5, kq = wave;
    const int n = nq4 * 32 + r32, nn = n < 127 ? n : 126;
    const bf16* arow = PROJ + (size_t)(b * SEQ + 16 * nn) * NPROJ + C_KV + kv * 128 + g * 64;
    const bf16* wt = (const bf16*)(A.ws + (kv ? WS_WCV : WS_WCK));
    f32x16 acc0, acc1;
#pragma unroll
    for (int r = 0; r < 16; ++r) { acc0[r] = 0.f; acc1[r] = 0.f; }
#pragma unroll 8
    for (int ks = 0; ks < 16; ++ks) { const int k0 = kq * 256 + ks * 16, l = k0 >> 6, d0 = k0 & 63;
        const bf16x8 a = *(const bf16x8*)(arow + (size_t)l * NPROJ + d0 + 8 * hi);
        const bf16x8 b0 = *(const bf16x8*)(wt + (size_t)r32 * 2048 + k0 + 8 * hi);
        const bf16x8 b1 = *(const bf16x8*)(wt + (size_t)(32 + r32) * 2048 + k0 + 8 * hi);
        acc0 = mfma32(a, b0, acc0); acc1 = mfma32(a, b1, acc1); }
    LAS float* RED = (LAS float*)lds;
    LAS float* BIAS = (LAS float*)(lds + 65536);
#pragma unroll
    for (int r = 0; r < 16; ++r) { const int row = crow(r, hi); RED[(kq * 32 + row) * 64 + r32] = acc0[r]; RED[(kq * 32 + row) * 64 + 32 + r32] = acc1[r]; }
    if (tid < 64) { const float* BP = (const float*)(A.ws + WS_BIASP) + kv * 32 * 64; float s = 0.f; for (int l = 0; l < 32; ++l) s += BP[l * 64 + tid]; BIAS[tid] = s; }
    __syncthreads();
    { const int row = tid >> 4, e0 = (tid & 15) * 4;
        float v[4];
#pragma unroll
        for (int i = 0; i < 4; ++i) { float s = BIAS[e0 + i];
#pragma unroll
            for (int q = 0; q < 8; ++q) s += RED[(q * 32 + row) * 64 + e0 + i];
            v[i] = s; }
        if (kv == 0) { float ss = (v[0] * v[0] + v[1] * v[1]) + (v[2] * v[2] + v[3] * v[3]);
            ss += __shfl_xor(ss, 1); ss += __shfl_xor(ss, 2); ss += __shfl_xor(ss, 4); ss += __shfl_xor(ss, 8);
            const float rstd = rsqrtf(ss * (1.0f / 64.0f) + EPS);
#pragma unroll
            for (int i = 0; i < 4; ++i) v[i] = v[i] * rstd * A.qkg[64 + e0 + i]; }
        const int ng = nq4 * 32 + row;
        if (ng == 127) {
#pragma unroll
            for (int i = 0; i < 4; ++i) v[i] = 0.f; }
        v2u o; o.x = cvtpk(v[0], v[1]); o.y = cvtpk(v[2], v[3]);
        *(v2u*)((bf16*)(A.ws + (kv ? WS_VC : WS_KC)) + ((size_t)(b * 2 + g) * 128 + ng) * 64 + e0) = o; }
    __syncthreads();
}

__device__ __forceinline__ void conv_unit(const Args& A, LAS unsigned char* lds, int u, int tid, int wave, int lane) {
    const bf16* PROJ = (const bf16*)(A.ws + WS_PROJ); bf16* MIX = (bf16*)(A.ws + WS_MIX);
    const int b = u >> 6, t0 = (u & 63) * 32, c = tid;
    LAS float* U = (LAS float*)lds;
#pragma unroll 1
    for (int p0 = 0; p0 < 62 * 64; p0 += 4 * NTHR) {
        v4u av[4], bv[4];
#pragma unroll
        for (int q = 0; q < 4; ++q) { const int p = p0 + q * NTHR + tid, i = p >> 6, ch = (p & 63) * 8, ts = t0 - 30 + i;
            if (p < 62 * 64 && ts >= 0) { const bf16* pr = PROJ + (size_t)(b * SEQ + ts) * NPROJ + C_GLU + ch; av[q] = *(const v4u*)pr; bv[q] = *(const v4u*)(pr + 512); }
            else { av[q] = (v4u){0u, 0u, 0u, 0u}; bv[q] = (v4u){0u, 0u, 0u, 0u}; } }
#pragma unroll
        for (int q = 0; q < 4; ++q) { const int p = p0 + q * NTHR + tid, i = p >> 6, ch = (p & 63) * 8;
            if (p < 62 * 64) { f32x4 u0, u1;
                u0[0] = bflo(av[q].x) * sigmoidf_(bflo(bv[q].x)); u0[1] = bfhi(av[q].x) * sigmoidf_(bfhi(bv[q].x)); u0[2] = bflo(av[q].y) * sigmoidf_(bflo(bv[q].y)); u0[3] = bfhi(av[q].y) * sigmoidf_(bfhi(bv[q].y));
                u1[0] = bflo(av[q].z) * sigmoidf_(bflo(bv[q].z)); u1[1] = bfhi(av[q].z) * sigmoidf_(bfhi(bv[q].z)); u1[2] = bflo(av[q].w) * sigmoidf_(bflo(bv[q].w)); u1[3] = bfhi(av[q].w) * sigmoidf_(bfhi(bv[q].w));
                *(LAS f32x4*)(U + i * 512 + ch) = u0; *(LAS f32x4*)(U + i * 512 + ch + 4) = u1; } }
    }
    float w[31];
#pragma unroll
    for (int k = 0; k < 31; ++k) w[k] = A.dw_w[k * 512 + c];
    const float bias = A.dw_b[c];
    __syncthreads();
    float y[32];
#pragma unroll
    for (int t = 0; t < 32; ++t) y[t] = bias;
#pragma unroll
    for (int i = 0; i < 62; ++i) { const float uv = U[i * 512 + c];
#pragma unroll
        for (int t = 0; t < 32; ++t) if (i - t >= 0 && i - t <= 30) y[t] += uv * w[i - t]; }
    __syncthreads();
#pragma unroll
    for (int t = 0; t < 32; ++t) U[t * 512 + c] = y[t];
    __syncthreads();
    f32x4 lg0 = *(const f32x4*)(A.ln_g + 8 * lane), lg1 = *(const f32x4*)(A.ln_g + 8 * lane + 4), lb0 = *(const f32x4*)(A.ln_b + 8 * lane), lb1 = *(const f32x4*)(A.ln_b + 8 * lane + 4);
    for (int tt = 0; tt < 4; ++tt) { const int t = wave * 4 + tt;
        f32x4 a0 = *(const LAS f32x4*)(U + t * 512 + 8 * lane), a1 = *(const LAS f32x4*)(U + t * 512 + 8 * lane + 4);
        float s = (a0[0] + a0[1]) + (a0[2] + a0[3]) + (a1[0] + a1[1]) + (a1[2] + a1[3]);
        const float mu = wave_sum(s) * (1.0f / 512.0f);
        a0 = a0 - mu; a1 = a1 - mu;
        float q = (a0[0] * a0[0] + a0[1] * a0[1]) + (a0[2] * a0[2] + a0[3] * a0[3]) + (a1[0] * a1[0] + a1[1] * a1[1]) + (a1[2] * a1[2] + a1[3] * a1[3]);
        const float rstd = rsqrtf(wave_sum(q) * (1.0f / 512.0f) + EPS);
        a0 = a0 * rstd * lg0 + lb0; a1 = a1 * rstd * lg1 + lb1;
        float o[8];
#pragma unroll
        for (int i = 0; i < 4; ++i) { o[i] = a0[i] * sigmoidf_(a0[i]); o[4 + i] = a1[i] * sigmoidf_(a1[i]); }
        v4u ov; ov.x = cvtpk(o[0], o[1]); ov.y = cvtpk(o[2], o[3]); ov.z = cvtpk(o[4], o[5]); ov.w = cvtpk(o[6], o[7]);
        *(v4u*)(MIX + (size_t)(b * SEQ + t0 + t) * DM + 512 + 8 * lane) = ov; }
    __syncthreads();
}

constexpr int A_K0 = 0, A_K1 = 8192, A_V0 = 16384, A_V1 = 24576, A_WSF = 32768, A_IMP = 36864, A_IMPS = 70656, A_SELM = 79104, A_ANY = 79360;
constexpr float NEG_MASK = -1e30f, M_INIT = -1e20f;

__device__ __forceinline__ void stage_kv(LAS unsigned char* lds, int koff, int voff, const bf16* Ksrc, const bf16* Vsrc, int wave, int lane) {
    const v4u kx = *(const v4u*)(Ksrc + lane * 64 + wave * 8);
    const v4u vx = *(const v4u*)(Vsrc + (16 * (wave & 3) + (lane >> 2)) * 64 + (wave >> 2) * 32 + (lane & 3) * 8);
    *(LAS v4u*)(lds + koff + wave * 1024 + lane * 16) = kx;
    *(LAS v4u*)(lds + voff + wave * 1024 + lane * 16) = vx;
}
__device__ __forceinline__ void qkt_acc(f32x16& p0, f32x16& p1, const LAS unsigned char* kslot, const bf16x8 (&qr)[4], int r32, int hi) {
    const LAS unsigned char* kb = kslot + hi * 1024 + r32 * 16;
#pragma unroll
    for (int d0 = 0; d0 < 4; ++d0) { const bf16x8 b0 = *(const LAS bf16x8*)(kb + d0 * 2048), b1 = *(const LAS bf16x8*)(kb + d0 * 2048 + 512);
        p0 = mfma32(b0, qr[d0], p0); p1 = mfma32(b1, qr[d0], p1); }
}
__device__ __forceinline__ void qkt(f32x16& p0, f32x16& p1, const LAS unsigned char* kslot, const bf16x8 (&qr)[4], int r32, int hi) {
    const LAS unsigned char* kb = kslot + hi * 1024 + r32 * 16;
#pragma unroll
    for (int r = 0; r < 16; ++r) { p0[r] = 0.f; p1[r] = 0.f; }
#pragma unroll
    for (int d0 = 0; d0 < 4; ++d0) { const bf16x8 b0 = *(const LAS bf16x8*)(kb + d0 * 2048), b1 = *(const LAS bf16x8*)(kb + d0 * 2048 + 512);
        p0 = mfma32(b0, qr[d0], p0); p1 = mfma32(b1, qr[d0], p1); }
}
__device__ __forceinline__ s16x4 vtr(const LAS unsigned char* p) { return __builtin_bit_cast(s16x4, __builtin_amdgcn_ds_read_tr16_b64_v4i16((LAS s16x4*)p)); }
__device__ __forceinline__ void pv(f32x16 (&o)[2], const LAS unsigned char* vslot, const f32x16& p0, const f32x16& p1, int lane, int hi) {
    const LAS unsigned char* vp = vslot + ((lane >> 4) & 1) * 32 + (lane & 3) * 8 + (4 * hi + ((lane & 15) >> 2)) * 64;
    v4u pw[4];
#pragma unroll
    for (int i = 0; i < 4; ++i) { pw[0][i] = cvtpk(p0[2 * i], p0[2 * i + 1]); pw[1][i] = cvtpk(p0[8 + 2 * i], p0[9 + 2 * i]); pw[2][i] = cvtpk(p1[2 * i], p1[2 * i + 1]); pw[3][i] = cvtpk(p1[8 + 2 * i], p1[9 + 2 * i]); }
#pragma unroll
    for (int d0 = 0; d0 < 2; ++d0)
#pragma unroll
        for (int ks = 0; ks < 4; ++ks) { const s16x4 lo = vtr(vp + d0 * 4096 + ks * 1024), hh = vtr(vp + d0 * 4096 + ks * 1024 + 512);
            const bf16x8 vf = (bf16x8){lo[0], lo[1], lo[2], lo[3], hh[0], hh[1], hh[2], hh[3]};
            o[d0] = mfma32(__builtin_bit_cast(bf16x8, pw[ks]), vf, o[d0]); }
}
__device__ __forceinline__ void row_bcast(float (&f)[16], float x, LAS float* wsf, int r32, int hi) {
    if (hi == 0) wsf[r32] = x;
#pragma unroll
    for (int g = 0; g < 4; ++g) { const f32x4 t = *(const LAS f32x4*)(wsf + 8 * g + 4 * hi); f[4 * g] = t[0]; f[4 * g + 1] = t[1]; f[4 * g + 2] = t[2]; f[4 * g + 3] = t[3]; }
}
__device__ __forceinline__ void tile_update(f32x16& p0, f32x16& p1, float& m, float& l, f32x16 (&o)[2], LAS float* wsf, const LAS unsigned char* vslot, int lane, int r32, int hi) {
    float rm = fmaxf(p0[0], p1[0]);
#pragma unroll
    for (int r = 1; r < 16; ++r) rm = fmaxf(rm, fmaxf(p0[r], p1[r]));
    rm = fmaxf(rm, swap32(rm));
    const float mn = fmaxf(m, rm), f = fast_exp2(m - mn);
    m = mn;
    float s = 0.f;
#pragma unroll
    for (int r = 0; r < 16; ++r) { p0[r] = fast_exp2(p0[r] - mn); p1[r] = fast_exp2(p1[r] - mn); s += p0[r] + p1[r]; }
    l = l * f + s;
    if (__any(f != 1.0f)) { float fr[16]; row_bcast(fr, f, wsf, r32, hi);
#pragma unroll
        for (int r = 0; r < 16; ++r) { o[0][r] *= fr[r]; o[1][r] *= fr[r]; } }
    pv(o, vslot, p0, p1, lane, hi);
}

__device__ __forceinline__ void tile_update_rel(f32x16& p0, f32x16& p1, float& m, float& l, f32x16 (&o)[2], const LAS unsigned char* vslot, int lane, int hi, bool first) {
    if (first) {
        float rm = fmaxf(p0[0], p1[0]);
#pragma unroll
        for (int r = 1; r < 16; ++r) rm = fmaxf(rm, fmaxf(p0[r], p1[r]));
        rm = fmaxf(pairmax32(rm), 0.f);
        m += rm;
#pragma unroll
        for (int r = 0; r < 16; ++r) { p0[r] -= rm; p1[r] -= rm; }
    }
    float s = 0.f;
#pragma unroll
    for (int r = 0; r < 16; ++r) { p0[r] = fast_exp2(p0[r]); p1[r] = fast_exp2(p1[r]); s += p0[r] + p1[r]; }
    l += s;
    pv(o, vslot, p0, p1, lane, hi);
}

__device__ __forceinline__ void attn_unit(const Args& A, LAS unsigned char* lds, int b, int g, int qt, int tid, int wave, int lane) {
    const bf16* PROJ = (const bf16*)(A.ws + WS_PROJ); bf16* MIX = (bf16*)(A.ws + WS_MIX);
    const bf16* KC = (const bf16*)(A.ws + WS_KC) + (size_t)(b * 2 + g) * 128 * 64; const bf16* VC = (const bf16*)(A.ws + WS_VC) + (size_t)(b * 2 + g) * 128 * 64;
    const bf16* KS = (const bf16*)(A.ws + WS_KS) + (size_t)(b * 2 + g) * SEQ * 64; const bf16* VS = (const bf16*)(A.ws + WS_VS) + (size_t)(b * 2 + g) * SEQ * 64;
    const bf16* KW = (const bf16*)(A.ws + WS_KW) + (size_t)(b * 2 + g) * SEQ * 64; const bf16* VW = (const bf16*)(A.ws + WS_VW) + (size_t)(b * 2 + g) * SEQ * 64;
    const int r32 = lane & 31, hi = lane >> 5, rh = wave >> 1, th = wave & 1, hr = g * 4 + rh;
    const int tq = qt * 64 + th * 32 + r32;
    const size_t row = (size_t)b * SEQ + tq;
    LAS float* wsf = (LAS float*)(lds + A_WSF) + wave * 128;
    LAS float* IMP = (LAS float*)(lds + A_IMP); LAS float* IMPS = (LAS float*)(lds + A_IMPS);
    LAS unsigned* SELM = (LAS unsigned*)(lds + A_SELM); LAS unsigned* ANYM = (LAS unsigned*)(lds + A_ANY);
    const float slope2 = exp2f(-(float)(hr + 1)) * LOG2E;
    bf16x8 qr[4];
    { float qv[32]; float ss = 0.f;
#pragma unroll
        for (int d0 = 0; d0 < 4; ++d0) { const v4u raw = *(const v4u*)(PROJ + row * NPROJ + hr * 64 + d0 * 16 + hi * 8);
            qv[8 * d0 + 0] = bflo(raw.x); qv[8 * d0 + 1] = bfhi(raw.x); qv[8 * d0 + 2] = bflo(raw.y); qv[8 * d0 + 3] = bfhi(raw.y);
            qv[8 * d0 + 4] = bflo(raw.z); qv[8 * d0 + 5] = bfhi(raw.z); qv[8 * d0 + 6] = bflo(raw.w); qv[8 * d0 + 7] = bfhi(raw.w); }
#pragma unroll
        for (int i = 0; i < 32; ++i) ss += qv[i] * qv[i];
        ss += swap32(ss);
        const float sc = rsqrtf(ss * (1.0f / 64.0f) + EPS) * (0.125f * LOG2E);
#pragma unroll
        for (int d0 = 0; d0 < 4; ++d0) { v4u w;
#pragma unroll
            for (int i = 0; i < 4; ++i) { const int d = d0 * 16 + hi * 8 + 2 * i; w[i] = cvtpk(qv[8 * d0 + 2 * i] * sc * A.qkg[d], qv[8 * d0 + 2 * i + 1] * sc * A.qkg[d + 1]); }
            qr[d0] = __builtin_bit_cast(bf16x8, w); } }
    const float g_c = sigmoidf_(bf2f(PROJ[row * NPROJ + C_GATE + hr * 3 + 0])), g_s = sigmoidf_(bf2f(PROJ[row * NPROJ + C_GATE + hr * 3 + 1])), g_w = sigmoidf_(bf2f(PROJ[row * NPROJ + C_GATE + hr * 3 + 2]));
    f32x16 oacc[2], o[2], p0, p1;
    if (tid < 64) SELM[tid] = 0u;
    if (tid == 64) ANYM[0] = 0u;
    const bool two = qt >= 16;
    stage_kv(lds, A_K0, A_V0, KC, VC, wave, lane);
    if (two) stage_kv(lds, A_K1, A_V1, KC + 64 * 64, VC + 64 * 64, wave, lane);
    __syncthreads();
    {
        f32x16 p2, p3;
        qkt(p0, p1, lds + A_K0, qr, r32, hi);
        if (two) qkt(p2, p3, lds + A_K1, qr, r32, hi);
        else {
#pragma unroll
            for (int r = 0; r < 16; ++r) { p2[r] = NEG_MASK; p3[r] = NEG_MASK; } }
        const float bd = (float)(tq - 31 - 64 * hi);
        float rm = NEG_MASK;
#pragma unroll
        for (int r = 0; r < 16; ++r) { const float c16 = (float)(16 * ((r & 3) + 8 * (r >> 2)));
            const float d0_ = bd - c16, d1_ = d0_ - 512.f, d2_ = d0_ - 1024.f, d3_ = d0_ - 1536.f;
            p0[r] = d0_ >= 0.f ? p0[r] - slope2 * d0_ : NEG_MASK; p1[r] = d1_ >= 0.f ? p1[r] - slope2 * d1_ : NEG_MASK;
            p2[r] = (two && d2_ >= 0.f) ? p2[r] - slope2 * d2_ : NEG_MASK; p3[r] = (two && d3_ >= 0.f) ? p3[r] - slope2 * d3_ : NEG_MASK;
            rm = fmaxf(fmaxf(rm, fmaxf(p0[r], p1[r])), fmaxf(p2[r], p3[r])); }
        rm = fmaxf(rm, swap32(rm));
        const bool has = rm > -1e29f; const float mref = has ? rm : 0.f;
        float s = 0.f;
#pragma unroll
        for (int r = 0; r < 16; ++r) { p0[r] = fast_exp2(p0[r] - mref); p1[r] = fast_exp2(p1[r] - mref); p2[r] = fast_exp2(p2[r] - mref); p3[r] = fast_exp2(p3[r] - mref); s += (p0[r] + p1[r]) + (p2[r] + p3[r]); }
        s += swap32(s);
        const float inv = has ? 1.0f / s : 0.f;
#pragma unroll
        for (int r = 0; r < 16; ++r) { p0[r] *= inv; p1[r] *= inv; p2[r] *= inv; p3[r] *= inv; }
        float av[16], bv[16];
#pragma unroll
        for (int gq = 0; gq < 4; ++gq) {
            av[gq] = p0[4 * gq] + p0[4 * gq + 1] + p0[4 * gq + 2] + 0.5f * p0[4 * gq + 3]; bv[gq] = 0.5f * p0[4 * gq + 3];
            av[4 + gq] = p1[4 * gq] + p1[4 * gq + 1] + p1[4 * gq + 2] + 0.5f * p1[4 * gq + 3]; bv[4 + gq] = 0.5f * p1[4 * gq + 3];
            av[8 + gq] = p2[4 * gq] + p2[4 * gq + 1] + p2[4 * gq + 2] + 0.5f * p2[4 * gq + 3]; bv[8 + gq] = 0.5f * p2[4 * gq + 3];
            av[12 + gq] = p3[4 * gq] + p3[4 * gq + 1] + p3[4 * gq + 2] + 0.5f * p3[4 * gq + 3]; bv[12 + gq] = 0.5f * p3[4 * gq + 3]; }
        float prev = 0.f;
#pragma unroll
        for (int q = 0; q < 16; ++q) { const float rc = swap32(bv[q]); const float v = av[q] + (hi ? rc : prev); prev = rc;
            IMP[(rh * 64 + th * 32 + r32) * 33 + 2 * q + hi] = v; }
#pragma unroll
        for (int r = 0; r < 16; ++r) { o[0][r] = 0.f; o[1][r] = 0.f; }
        pv(o, lds + A_V0, p0, p1, lane, hi);
        if (two) pv(o, lds + A_V1, p2, p3, lane, hi);
        float fr[16]; row_bcast(fr, g_c, wsf, r32, hi);
#pragma unroll
        for (int r = 0; r < 16; ++r) { oacc[0][r] = o[0][r] * fr[r]; oacc[1][r] = o[1][r] * fr[r]; }
    }
    __syncthreads();
    { const int tok = tid >> 3, jq = tid & 7;
#pragma unroll
        for (int i = 0; i < 4; ++i) { const int j = 4 * jq + i; IMPS[tok * 33 + j] = (IMP[(0 * 64 + tok) * 33 + j] + IMP[(1 * 64 + tok) * 33 + j]) + (IMP[(2 * 64 + tok) * 33 + j] + IMP[(3 * 64 + tok) * 33 + j]); } }
    __syncthreads();
    { const int tok = tid >> 3, jq = tid & 7; unsigned bits = 0u;
        if (qt >= 16) { unsigned kk[32];
#pragma unroll
            for (int j = 0; j < 32; ++j) { const unsigned fb = __float_as_uint(IMPS[tok * 33 + j]); kk[j] = (j >= 1 && j <= qt - 2) ? ((fb & ~31u) | (unsigned)(31 - j)) : 0u; }
#pragma unroll
            for (int i = 0; i < 4; ++i) { const int j = 4 * jq + i; const unsigned kj = (__float_as_uint(IMPS[tok * 33 + j]) & ~31u) | (unsigned)(31 - j);
                int cnt = 0;
#pragma unroll
                for (int jj = 1; jj < 31; ++jj) cnt += (kk[jj] > kj) ? 1 : 0;
                const bool forced = (j == 0) || (j == qt) || (j == qt - 1);
                const bool sel = forced || (j >= 1 && j <= qt - 2 && cnt < 13);
                bits |= sel ? (1u << j) : 0u; } }
        else {
#pragma unroll
            for (int i = 0; i < 4; ++i) { const int j = 4 * jq + i; bits |= (j <= qt) ? (1u << j) : 0u; } }
        atomicOr((unsigned*)&SELM[tok], bits); atomicOr((unsigned*)&ANYM[0], bits); }
    __syncthreads();
    const unsigned mysel = SELM[th * 32 + r32], anym = ANYM[0];
    float m = 0.f, l = 0.f;
#pragma unroll
    for (int r = 0; r < 16; ++r) { o[0][r] = 0.f; o[1][r] = 0.f; }
    const int jlo = qt >= 8 ? qt - 8 : 0, nwt = qt - jlo + 1;
    unsigned rem = (unsigned)__builtin_amdgcn_readfirstlane((int)(anym & (qt == 31 ? 0xFFFFFFFFu : ((2u << qt) - 1u))));
    int wi = 0;
#define ATT_NEXT(kind_, j_, ok_) do { if (rem) { kind_ = 0; j_ = 31 - __builtin_clz(rem); rem &= ~(1u << j_); ok_ = true; } \
        else if (wi < nwt) { kind_ = 1; j_ = qt - wi; ++wi; ok_ = true; } else { ok_ = false; } } while (0)
#define ATT_LOAD(kind_, j_, kx_, vx_) do { const bf16* Kp_ = ((kind_) ? KW : KS) + (size_t)(j_) * 4096; const bf16* Vp_ = ((kind_) ? VW : VS) + (size_t)(j_) * 4096; \
        kx_ = *(const v4u*)(Kp_ + lane * 64 + wave * 8); vx_ = *(const v4u*)(Vp_ + (16 * (wave & 3) + (lane >> 2)) * 64 + (wave >> 2) * 32 + (lane & 3) * 8); } while (0)
#define ATT_STORE(slot_, kx_, vx_) do { *(LAS v4u*)(lds + ((slot_) ? A_K1 : A_K0) + wave * 1024 + lane * 16) = kx_; *(LAS v4u*)(lds + ((slot_) ? A_V1 : A_V0) + wave * 1024 + lane * 16) = vx_; } while (0)
    int ck, cj, nk = 0, nj = 0; bool cok, nok; v4u kx, vx;
    ATT_NEXT(ck, cj, cok);
    ATT_LOAD(ck, cj, kx, vx); ATT_STORE(0, kx, vx);
    ATT_NEXT(nk, nj, nok);
    __syncthreads();
    int slot = 0, pk = 0; bool first = true;
    while (cok) {
        if (nok) ATT_LOAD(nk, nj, kx, vx);
        if (ck != pk) {
            l = pairsum32(l); float fr[16]; row_bcast(fr, g_s / l, wsf, r32, hi);
#pragma unroll
            for (int r = 0; r < 16; ++r) { oacc[0][r] += o[0][r] * fr[r]; oacc[1][r] += o[1][r] * fr[r]; o[0][r] = 0.f; o[1][r] = 0.f; }
            m = 0.f; l = 0.f; pk = ck; first = true; }
        const bool isw = ck != 0; const bool ok = isw || ((mysel >> cj) & 1u); const float bd = (float)(tq - 64 * cj - 4 * hi);
        if (cj != qt && !(isw && cj == qt - 8)) {
            const float beff = ok ? -slope2 * bd - m : NEG_MASK;
#pragma unroll
            for (int r = 0; r < 16; ++r) { p0[r] = fmaf(slope2, (float)((r & 3) + 8 * (r >> 2)), beff); p1[r] = fmaf(slope2, (float)((r & 3) + 8 * (r >> 2) + 32), beff); }
            qkt_acc(p0, p1, lds + (slot ? A_K1 : A_K0), qr, r32, hi);
        } else {
            qkt(p0, p1, lds + (slot ? A_K1 : A_K0), qr, r32, hi);
            const float lim = isw ? 512.f : 1e9f;
#pragma unroll
            for (int r = 0; r < 16; ++r) { const float d0_ = bd - (float)((r & 3) + 8 * (r >> 2)), d1_ = d0_ - 32.f;
                p0[r] = (ok && d0_ >= 0.f && d0_ < lim) ? p0[r] - slope2 * d0_ - m : NEG_MASK; p1[r] = (ok && d1_ >= 0.f && d1_ < lim) ? p1[r] - slope2 * d1_ - m : NEG_MASK; } }
        tile_update_rel(p0, p1, m, l, o, lds + (slot ? A_V1 : A_V0), lane, hi, first); first = false;
        if (nok) ATT_STORE(slot ^ 1, kx, vx);
        __syncthreads();
        slot ^= 1; ck = nk; cj = nj; cok = nok;
        if (cok) ATT_NEXT(nk, nj, nok);
    }
    { l = pairsum32(l); float fr[16]; row_bcast(fr, g_w / l, wsf, r32, hi);
#pragma unroll
        for (int r = 0; r < 16; ++r) { oacc[0][r] += o[0][r] * fr[r]; oacc[1][r] += o[1][r] * fr[r]; } }
#undef ATT_NEXT
#undef ATT_LOAD
#undef ATT_STORE
    { bf16* ob = MIX + ((size_t)b * SEQ + qt * 64 + th * 32) * DM + hr * 64 + r32;
#pragma unroll
        for (int r = 0; r < 16; ++r) { const int q = crow(r, hi);
            ob[(size_t)q * DM] = (bf16)(cvtpk(oacc[0][r], 0.f) & 0xffffu); ob[(size_t)q * DM + 32] = (bf16)(cvtpk(oacc[1][r], 0.f) & 0xffffu); } }
    __syncthreads();
}

__device__ __forceinline__ void ins16(float (&L)[16], float x) {
#pragma unroll
    for (int i = 15; i >= 1; --i) L[i] = __builtin_amdgcn_fmed3f(x, L[i - 1], L[i]);
    L[0] = fmaxf(L[0], x);
}
__device__ __forceinline__ float sel16(const float (&L)[16], int a) { float r = L[0];
#pragma unroll
    for (int i = 1; i < 16; ++i) r = (a == i) ? L[i] : r;
    return r; }
#define CE(hi_, lo_) do { float t_, u_; asm("v_max_f32 %0, %1, %2" : "=v"(t_) : "v"(hi_), "v"(lo_)); asm("v_min_f32 %0, %1, %2" : "=v"(u_) : "v"(hi_), "v"(lo_)); hi_ = t_; lo_ = u_; } while (0)
#define SORT16_DESC(A) do { CE(A[0], A[1]); CE(A[3], A[2]); CE(A[4], A[5]); CE(A[7], A[6]); CE(A[8], A[9]); CE(A[11], A[10]); CE(A[12], A[13]); CE(A[15], A[14]); CE(A[0], A[2]); CE(A[1], A[3]); CE(A[6], A[4]); CE(A[7], A[5]); CE(A[8], A[10]); CE(A[9], A[11]); CE(A[14], A[12]); CE(A[15], A[13]); CE(A[0], A[1]); CE(A[2], A[3]); CE(A[5], A[4]); CE(A[7], A[6]); CE(A[8], A[9]); CE(A[10], A[11]); CE(A[13], A[12]); CE(A[15], A[14]); CE(A[0], A[4]); CE(A[1], A[5]); CE(A[2], A[6]); CE(A[3], A[7]); CE(A[12], A[8]); CE(A[13], A[9]); CE(A[14], A[10]); CE(A[15], A[11]); CE(A[0], A[2]); CE(A[1], A[3]); CE(A[4], A[6]); CE(A[5], A[7]); CE(A[10], A[8]); CE(A[11], A[9]); CE(A[14], A[12]); CE(A[15], A[13]); CE(A[0], A[1]); CE(A[2], A[3]); CE(A[4], A[5]); CE(A[6], A[7]); CE(A[9], A[8]); CE(A[11], A[10]); CE(A[13], A[12]); CE(A[15], A[14]); CE(A[0], A[8]); CE(A[1], A[9]); CE(A[2], A[10]); CE(A[3], A[11]); CE(A[4], A[12]); CE(A[5], A[13]); CE(A[6], A[14]); CE(A[7], A[15]); CE(A[0], A[4]); CE(A[1], A[5]); CE(A[2], A[6]); CE(A[3], A[7]); CE(A[8], A[12]); CE(A[9], A[13]); CE(A[10], A[14]); CE(A[11], A[15]); CE(A[0], A[2]); CE(A[1], A[3]); CE(A[4], A[6]); CE(A[5], A[7]); CE(A[8], A[10]); CE(A[9], A[11]); CE(A[12], A[14]); CE(A[13], A[15]); CE(A[0], A[1]); CE(A[2], A[3]); CE(A[4], A[5]); CE(A[6], A[7]); CE(A[8], A[9]); CE(A[10], A[11]); CE(A[12], A[13]); CE(A[14], A[15]); } while (0)
#define MERGE16_DESC(A) do { CE(A[0], A[8]); CE(A[1], A[9]); CE(A[2], A[10]); CE(A[3], A[11]); CE(A[4], A[12]); CE(A[5], A[13]); CE(A[6], A[14]); CE(A[7], A[15]); CE(A[0], A[4]); CE(A[1], A[5]); CE(A[2], A[6]); CE(A[3], A[7]); CE(A[8], A[12]); CE(A[9], A[13]); CE(A[10], A[14]); CE(A[11], A[15]); CE(A[0], A[2]); CE(A[1], A[3]); CE(A[4], A[6]); CE(A[5], A[7]); CE(A[8], A[10]); CE(A[9], A[11]); CE(A[12], A[14]); CE(A[13], A[15]); CE(A[0], A[1]); CE(A[2], A[3]); CE(A[4], A[5]); CE(A[6], A[7]); CE(A[8], A[9]); CE(A[10], A[11]); CE(A[12], A[13]); CE(A[14], A[15]); } while (0)
__device__ __forceinline__ float vmaxf_(float a, float b) { float r; asm("v_max_f32 %0, %1, %2" : "=v"(r) : "v"(a), "v"(b)); return r; }
constexpr int SK_ROW = 136;
__device__ __forceinline__ void peer_half(const bf16* QP, const LAS bf16* SK, int t0, int h, int c, int r32, int hi, float (&Lc)[16]) {
    f32x16 acc[4];
#pragma unroll
    for (int kt = 0; kt < 4; ++kt)
#pragma unroll
        for (int r = 0; r < 16; ++r) acc[kt][r] = 0.f;
    bf16x8 bq[8];
#pragma unroll
    for (int ks = 0; ks < 8; ++ks) bq[ks] = *(const bf16x8*)(QP + (size_t)(t0 + r32) * NQP + h * 256 + c * 128 + ks * 16 + hi * 8);
#pragma unroll
    for (int ks = 0; ks < 8; ++ks) {
#pragma unroll
        for (int kt = 0; kt < 4; ++kt) { const bf16x8 ak = *(const LAS bf16x8*)(SK + (c * 128 + kt * 32 + r32) * SK_ROW + ks * 16 + hi * 8); acc[kt] = mfma32(ak, bq[ks], acc[kt]); } }
    float g0[16], g1[16], g2[16], g3[16];
#pragma unroll
    for (int r = 0; r < 16; ++r) { const unsigned kb = (unsigned)((r & 3) + 8 * (r >> 2) + 4 * hi);
        g0[r] = __uint_as_float((__float_as_uint(acc[0][r]) & ~0x7Fu) | (127u - kb)); g1[r] = __uint_as_float((__float_as_uint(acc[1][r]) & ~0x7Fu) | (95u - kb));
        g2[r] = __uint_as_float((__float_as_uint(acc[2][r]) & ~0x7Fu) | (63u - kb)); g3[r] = __uint_as_float((__float_as_uint(acc[3][r]) & ~0x7Fu) | (31u - kb)); }
    SORT16_DESC(g0); SORT16_DESC(g1); SORT16_DESC(g2); SORT16_DESC(g3);
#pragma unroll
    for (int i = 0; i < 16; ++i) { g0[i] = vmaxf_(g0[i], g1[15 - i]); g2[i] = vmaxf_(g2[i], g3[15 - i]); }
    MERGE16_DESC(g0); MERGE16_DESC(g2);
#pragma unroll
    for (int i = 0; i < 16; ++i) Lc[i] = vmaxf_(g0[i], g2[15 - i]);
    MERGE16_DESC(Lc);
    float P[16];
#pragma unroll
    for (int i = 0; i < 16; ++i) P[i] = swap32(Lc[15 - i]);
#pragma unroll
    for (int i = 0; i < 16; ++i) Lc[i] = vmaxf_(Lc[i], P[i]);
    MERGE16_DESC(Lc);
}
__device__ __forceinline__ void peer_stage_subkeys(const Args& A, LAS unsigned char* lds, int h, int tid) {
    const bf16* SUBK = (const bf16*)(A.ws + WS_SUBK) + (size_t)h * 2 * 128 * 128; LAS bf16* SK = (LAS bf16*)lds;
    for (int c = tid; c < 256 * 16; c += NTHR) { const int row = c >> 4, ch = c & 15; *(LAS v4u*)(SK + row * SK_ROW + ch * 8) = *(const v4u*)(SUBK + row * 128 + ch * 8); }
    __syncthreads();
}
__device__ __forceinline__ void peer_topk_unit(const Args& A, LAS unsigned char* lds, int h, int tb, int wave, int lane) {
    const bf16* QP = (const bf16*)(A.ws + WS_QP); const LAS bf16* SK = (const LAS bf16*)lds;
    const int r32 = lane & 31, hi = lane >> 5, t0 = tb * 256 + wave * 32;
    float L0[16], L1[16];
    peer_half(QP, SK, t0, h, 0, r32, hi, L0);
    peer_half(QP, SK, t0, h, 1, r32, hi, L1);
    LAS int* IDXT = (LAS int*)(lds + 69632) + wave * (32 * 33) + r32 * 33;
#pragma unroll
    for (int i = 0; i < 16; ++i) { IDXT[i] = 127 - (int)(__float_as_uint(L0[i]) & 0x7Fu); IDXT[16 + i] = 127 - (int)(__float_as_uint(L1[i]) & 0x7Fu); }
    float F[16];
#pragma unroll
    for (int bb = 0; bb < 16; ++bb) { const float v = __uint_as_float(__float_as_uint(L0[0]) & ~0x7Fu) + __uint_as_float(__float_as_uint(L1[bb]) & ~0x7Fu);
        F[bb] = __uint_as_float((__float_as_uint(v) & ~0xFFu) | (255u - (unsigned)bb)); }
#pragma unroll
    for (int a = 1; a < 16; ++a)
#pragma unroll
        for (int bb = 0; bb < 16; ++bb) if ((a + 1) * (bb + 1) <= 16) {
            const float v = __uint_as_float(__float_as_uint(L0[a]) & ~0x7Fu) + __uint_as_float(__float_as_uint(L1[bb]) & ~0x7Fu);
            ins16(F, __uint_as_float((__float_as_uint(v) & ~0xFFu) | (255u - (unsigned)(a * 16 + bb)))); }
    float sv[16]; int ev[16]; float sum = 0.f;
    const float mx = __uint_as_float(__float_as_uint(F[0]) & ~0xFFu);
#pragma unroll
    for (int k = 0; k < 16; ++k) { const unsigned code = 255u - (__float_as_uint(F[k]) & 0xFFu); const int a = (int)(code >> 4), bb = (int)(code & 15u);
        const float s = __uint_as_float(__float_as_uint(F[k]) & ~0xFFu);
        const int i1 = IDXT[a], i2 = IDXT[16 + bb];
        ev[k] = i1 * 128 + i2; sv[k] = __expf(s - mx); sum += sv[k]; }
    const float inv = 1.0f / sum;
    { const float* SU = (const float*)(A.ws + WS_SU); const float* SV = (const float*)(A.ws + WS_SV);
      v2u* EG = (v2u*)(A.ws + WS_ENTG) + (size_t)(t0 + r32) * 128 + h * 16 + hi * 8;
#pragma unroll
      for (int k = 0; k < 16; ++k) { if ((k >> 3) == hi) { const int e = ev[k]; const unsigned gwb = cvtpk(sv[k] * inv, 0.f) & 0x7FFFu;
            EG[k & 7] = (v2u){(unsigned)e | (gwb << 17), cvtpk(SU[e], SV[e])}; } } }
}
__device__ __forceinline__ void peer_order_wave(const Args& A, LAS unsigned char* lds, int wg, int wave, int lane) {
    LAS unsigned* Hc = (LAS unsigned*)lds + wave * 256; LAS unsigned* S1 = Hc + 128;
    Hc[lane] = 0u; Hc[64 + lane] = 0u;
    const v2u* EG = (const v2u*)(A.ws + WS_ENTG) + (size_t)wg * 1024;
    unsigned w0r[16], w1r[16], rr[16];
#pragma unroll
    for (int j = 0; j < 16; ++j) { const v2u w = EG[j * 64 + lane]; w0r[j] = w.x | ((unsigned)(j >> 1) << 14); w1r[j] = w.y; }
#pragma unroll
    for (int j = 0; j < 16; ++j) { const unsigned sl = (w0r[j] & 0x3FFFu) >> 8; rr[j] = atomicAdd((unsigned*)&Hc[sl * 2 + (j >> 3)], 1u); }
    const unsigned c0 = Hc[2 * lane], c1 = Hc[2 * lane + 1], p0 = c0, p1 = c1, tot = p0 + p1;
    unsigned incl = tot;
#pragma unroll
    for (int o = 1; o < 64; o <<= 1) { const unsigned up = __shfl_up(incl, o); incl += (lane >= o) ? up : 0u; }
    const unsigned base0 = incl - tot, base1 = base0 + p0;
    S1[2 * lane] = base0; S1[2 * lane + 1] = base1;
    unsigned char* MB = A.ws + WS_META + (size_t)wg * META_STRIDE;
    v2u* MG = (v2u*)(MB + 128);
#pragma unroll
    for (int j = 0; j < 16; ++j) { const unsigned sl = (w0r[j] & 0x3FFFu) >> 8; const unsigned pos = S1[sl * 2 + (j >> 3)] + rr[j];
        MG[pos] = (v2u){w0r[j], w1r[j]}; }
}

__device__ __forceinline__ void glds16s(const void* sbase, unsigned voff, unsigned ldsaddr) {
    asm volatile("s_mov_b32 m0, %2\n\ts_nop 0\n\tglobal_load_lds_dwordx4 %0, %1" : : "v"(voff), "s"(sbase), "s"(ldsaddr) : "memory", "m0");
}
__device__ __forceinline__ float gelu_erf(float v) {
    const float av = fabsf(v), t = __builtin_amdgcn_rcpf(av * 0.2316418882f + 1.0f);
    float q = t * 0.5307027145f + (-0.7265760135f); q = q * t + 0.7107068705f; q = q * t + (-0.142248368f); q = q * t + 0.127414796f; q = q * t;
    const float e = __builtin_amdgcn_exp2f((v * v) * (-0.72134752044f)), m = v * (q * e);
    return v < 0.f ? m : v - m;
}
__device__ __forceinline__ void peer_gather_wave(const Args& A, LAS unsigned char* lds, int wg, int wave, int lane, bool final_pass) {
    const unsigned char* U8 = A.ws + WS_U8; const unsigned char* V8 = A.ws + WS_V8; const unsigned char* H8 = A.ws + WS_H8;
    const float* SH = (const float*)(A.ws + WS_SH); const float* MODF = (const float*)(A.ws + WS_MOD);
    LAS unsigned char* GBUF = lds + wave * PG_WSTRIDE;
    const unsigned gbuf_addr = (unsigned)__builtin_amdgcn_readfirstlane((int)(unsigned)(uintptr_t)GBUF);
    const unsigned metaw_addr = gbuf_addr + 16384;
    LAS unsigned* METAW = (LAS unsigned*)(lds + wave * PG_WSTRIDE + 16384);
    LAS unsigned short* AT = (LAS unsigned short*)(lds + wave * PG_WSTRIDE + 17408);
    LAS float* SHT = (LAS float*)(lds + LDS_CTL_OFF + 256 + wave * 32);
    const unsigned char* MB = A.ws + WS_META + (size_t)wg * META_STRIDE;
    const unsigned char* MGL = MB + 128 + 16 * (lane & 31);
    if (lane < 8) SHT[lane] = SH[8 * wg + lane];
    constexpr int ngtot = 256;
#define PG_META_CHUNK(c_) do { if (lane < 32) glds16s(MB, (unsigned)(128 + 16 * (lane & 31) + (c_) * 512), metaw_addr + ((c_) & 1) * 512); } while (0)
    PG_META_CHUNK(0); PG_META_CHUNK(1);
    asm volatile("s_waitcnt vmcnt(0) lgkmcnt(0)" ::: "memory");
    {
        const int ntot = 4 * ngtot, ng16 = (ntot + 15) >> 4;
        const int jl = lane & 15, kq = lane >> 4;
        v4i HA[16];
#pragma unroll
        for (int ks = 0; ks < 16; ++ks) HA[ks] = jl < 8 ? *(const v4i*)(H8 + (size_t)(8 * wg + jl) * DM + 64 * ks + 16 * kq) : (v4i){0, 0, 0, 0};
#define PGA_BASES(g_, B_) do { _Pragma("unroll") for (int d_ = 0; d_ < 4; ++d_) { int idx_ = 16 * (g_) + 4 * d_ + kq; idx_ = idx_ < ntot ? idx_ : ntot - 1; \
            const unsigned e_ = METAW[(idx_ & 127) * 2] & 0x3FFFu; B_[d_] = e_ * DM + ((jl ^ (4 * d_ + kq)) << 4); } } while (0)
#define PGA_ISSUE(B_, q_) do { _Pragma("unroll") for (int d_ = 0; d_ < 4; ++d_) glds16s(U8, B_[d_] + (q_) * 256, gbuf_addr + (q_) * 4096 + d_ * 1024); } while (0)
#define PGA_MMA(q_) do { const LAS unsigned char* gb_ = GBUF + (q_) * 4096 + jl * 256; _Pragma("unroll") for (int k4_ = 0; k4_ < 4; ++k4_) { \
            const v4i bf_ = *(const LAS v4i*)(gb_ + (((4 * k4_ + kq) ^ jl) << 4)); zacc = __builtin_amdgcn_mfma_i32_16x16x64_i8(HA[4 * (q_) + k4_], bf_, zacc, 0, 0, 0); } asm volatile("s_waitcnt lgkmcnt(0)" ::: "memory"); } while (0)
        unsigned bc[4], bn[4];
        PGA_BASES(0, bc);
        PGA_ISSUE(bc, 0); PGA_ISSUE(bc, 1); PGA_ISSUE(bc, 2);
        for (int g = 0; g < ng16; ++g) {
            if ((g & 3) == 0 && g > 0 && (g >> 2) + 1 <= 21) PG_META_CHUNK((g >> 2) + 1);
            const int gn = g + 1 < ng16 ? g + 1 : ng16 - 1;
            PGA_BASES(gn, bn);
            v4i zacc = (v4i){0, 0, 0, 0};
            PGA_ISSUE(bc, 3);
            asm volatile("s_waitcnt vmcnt(12)" ::: "memory"); PGA_MMA(0);
            PGA_ISSUE(bn, 0);
            asm volatile("s_waitcnt vmcnt(12)" ::: "memory"); PGA_MMA(1);
            PGA_ISSUE(bn, 1);
            asm volatile("s_waitcnt vmcnt(12)" ::: "memory"); PGA_MMA(2);
            PGA_ISSUE(bn, 2);
            asm volatile("s_waitcnt vmcnt(12)" ::: "memory"); PGA_MMA(3);
            { const int idx = 16 * g + jl; const unsigned w0 = METAW[(idx & 127) * 2], w1 = METAW[(idx & 127) * 2 + 1]; const unsigned tj = (w0 >> 14) & 7u;
              if (idx < ntot && (int)(tj >> 2) == kq) { const unsigned ts = tj & 3u; const int zi = ts == 0 ? zacc[0] : ts == 1 ? zacc[1] : ts == 2 ? zacc[2] : zacc[3];
                  const float z = (float)zi * bflo(w1) * SHT[tj];
                  AT[idx] = (unsigned short)((cvtpk(__uint_as_float((w0 >> 17) << 16) * gelu_erf(z) * bfhi(w1), 0.f) & 0xFFF8u) | tj); } }
#pragma unroll
            for (int d = 0; d < 4; ++d) bc[d] = bn[d];
        }
#undef PGA_BASES
#undef PGA_ISSUE
#undef PGA_MMA
    }
    asm volatile("s_waitcnt vmcnt(0) lgkmcnt(0)" ::: "memory");
    const int ntot = 4 * ngtot, nblk = (ntot + 31) >> 5;
    LAS unsigned char* A8 = (LAS unsigned char*)AT; LAS unsigned char* TK = A8 + 1408;
    float sa;
    {
        unsigned raw[22]; float cm = 0.f;
#pragma unroll
        for (int i = 0; i < 22; ++i) { const int n = lane + 64 * i; raw[i] = n < ntot ? (unsigned)AT[n] : 0u; cm = fmaxf(cm, fabsf(__uint_as_float((raw[i] & 0xFFF8u) << 16))); }
#pragma unroll
        for (int o = 1; o < 64; o <<= 1) cm = fmaxf(cm, __shfl_xor(cm, o));
        sa = cm > 0.f ? cm * (1.0f / 256.0f) : 1.0f; const float isa = 1.0f / sa;
        asm volatile("s_waitcnt lgkmcnt(0)" ::: "memory");
#pragma unroll
        for (int i = 0; i < 22; ++i) { const int n = lane + 64 * i; const float c = __uint_as_float((raw[i] & 0xFFF8u) << 16) * isa;
            A8[n] = (unsigned char)(__builtin_amdgcn_cvt_pk_fp8_f32(c, 0.f, 0, false) & 0xFF); TK[n] = (unsigned char)(raw[i] & 7u); }
        asm volatile("s_waitcnt lgkmcnt(0)" ::: "memory");
    }
    const int i16 = lane & 15, kq = lane >> 4;
    const int tb_ent = 8 * kq + (i16 >> 1);
    const int tb_off = tb_ent * 128 + 8 * (i16 & 1), tb_swz = (tb_ent >> 1) & 7;
    const float* gf = MODF + ((8 * wg) >> 11) * NMOD + 5 * DM;
    for (int ch = 0; ch < 2; ++ch) {
        f32x4 acc[32];
#pragma unroll
        for (int T = 0; T < 32; ++T) acc[T] = (f32x4){0.f, 0.f, 0.f, 0.f};
        PG_META_CHUNK(0); PG_META_CHUNK(1);
        asm volatile("s_waitcnt vmcnt(0) lgkmcnt(0)" ::: "memory");
#define PGB_BASE1(kb_, d_, sw_) ({ int idx_ = 32 * (kb_) + 8 * (d_) + (lane >> 3); idx_ = idx_ < ntot ? idx_ : ntot - 1; ((METAW[(idx_ & 127) * 2] & 0x3FFFu) << 10) + (unsigned)(ch * 512) + (sw_); })
#define PGB_SWZ(d_) ((unsigned)(((lane & 7) ^ ((8 * (d_) + (lane >> 3)) >> 1)) & 7) << 4)
#define PGB_BASES(kb_, B_) do { B_[0] = PGB_BASE1(kb_, 0, PGB_SWZ(0)); B_[1] = PGB_BASE1(kb_, 1, PGB_SWZ(1)); B_[2] = PGB_BASE1(kb_, 2, PGB_SWZ(2)); B_[3] = PGB_BASE1(kb_, 3, PGB_SWZ(3)); } while (0)
#define PGB_ISSUE(B_, q_) do { _Pragma("unroll") for (int d_ = 0; d_ < 4; ++d_) glds16s(V8, B_[d_] + (q_) * 128, gbuf_addr + (q_) * 4096 + d_ * 1024); } while (0)
#define PGB_MMA(q_) do { const LAS unsigned char* gb_ = GBUF + (q_) * 4096 + tb_off; _Pragma("unroll") for (int nt_ = 0; nt_ < 8; ++nt_) { \
            const v2i bf_ = __builtin_amdgcn_ds_read_tr8_b64_v2i32((LAS v2i*)(gb_ + ((nt_ ^ tb_swz) << 4))); \
            acc[8 * (q_) + nt_] = __builtin_amdgcn_mfma_f32_16x16x32_fp8_fp8(aop, __builtin_bit_cast(long, bf_), acc[8 * (q_) + nt_], 0, 0, 0); } \
            asm volatile("s_waitcnt lgkmcnt(0)" ::: "memory"); } while (0)
        unsigned bc[4], bn[4];
        PGB_BASES(0, bc);
        PGB_ISSUE(bc, 0); PGB_ISSUE(bc, 1); PGB_ISSUE(bc, 2);
        for (int kb = 0; kb < nblk; ++kb) {
            if ((kb & 1) == 0 && kb > 0 && (kb >> 1) + 1 <= 21) PG_META_CHUNK((kb >> 1) + 1);
            const int kn = kb + 1 < nblk ? kb + 1 : nblk - 1;
            PGB_BASES(kn, bn);
            long aop;
            { const v2u a8 = *(const LAS v2u*)(A8 + 32 * kb + 8 * kq), tk = *(const LAS v2u*)(TK + 32 * kb + 8 * kq); const unsigned mm = (unsigned)i16 * 0x01010101u;
              unsigned x0 = tk.x ^ mm, x1 = tk.y ^ mm;
              x0 = ((x0 & 0x7F7F7F7Fu) + 0x7F7F7F7Fu) | x0; x1 = ((x1 & 0x7F7F7F7Fu) + 0x7F7F7F7Fu) | x1;
              const unsigned k0 = ((~x0 & 0x80808080u) >> 7) * 0xFFu, k1 = ((~x1 & 0x80808080u) >> 7) * 0xFFu;
              aop = (long)(((unsigned long long)(a8.y & k1) << 32) | (unsigned long long)(a8.x & k0)); }
            PGB_ISSUE(bc, 3);
            asm volatile("s_waitcnt vmcnt(12)" ::: "memory"); PGB_MMA(0);
            PGB_ISSUE(bn, 0);
            asm volatile("s_waitcnt vmcnt(12)" ::: "memory"); PGB_MMA(1);
            PGB_ISSUE(bn, 1);
            asm volatile("s_waitcnt vmcnt(12)" ::: "memory"); PGB_MMA(2);
            PGB_ISSUE(bn, 2);
            asm volatile("s_waitcnt vmcnt(12)" ::: "memory"); PGB_MMA(3);
#pragma unroll
            for (int d = 0; d < 4; ++d) bc[d] = bn[d];
        }
#undef PGB_BASE1
#undef PGB_SWZ
#undef PGB_BASES
#undef PGB_ISSUE
#undef PGB_MMA
        asm volatile("s_waitcnt vmcnt(0) lgkmcnt(0)" ::: "memory");
        { LAS float* EP = (LAS float*)GBUF;
#pragma unroll
          for (int hq = 0; hq < 2; ++hq) {
            const int col = ch * 512 + hq * 256 + 4 * lane; const f32x4 g = *(const f32x4*)(gf + col) * sa;
            const float* xin = A.out + (size_t)(8 * wg) * DM + col; float* xout = final_pass ? A.out + (size_t)(8 * wg) * DM + col : (float*)(A.ws + WS_H) + (size_t)(8 * (wg & 511)) * DM + col;
            if (kq < 2) {
#pragma unroll
                for (int T = 0; T < 16; ++T)
#pragma unroll
                    for (int r = 0; r < 4; ++r) EP[(4 * kq + r) * 256 + T * 16 + i16] = acc[16 * hq + T][r]; }
            asm volatile("s_waitcnt lgkmcnt(0)" ::: "memory");
#pragma unroll 4
            for (int t = 0; t < 8; ++t) { const f32x4 v = *(const LAS f32x4*)(EP + t * 256 + 4 * lane);
                *(f32x4*)(xout + (size_t)t * DM) = *(const f32x4*)(xin + (size_t)t * DM) + g * v; }
            asm volatile("s_waitcnt lgkmcnt(0)" ::: "memory"); } }
    }
#undef PG_META_CHUNK
#undef PG_ISSUE_GROUP
#undef PG_META_GROUP
}

#define RLX_AGENT __ATOMIC_RELAXED, __HIP_MEMORY_SCOPE_AGENT
constexpr size_t WS_CTL = 240 * MiB, CTL_ZERO_BYTES = 65536;
constexpr int MISC_OFF = LDS_CTL_OFF + 64;
#define XB_TMO      128
#define XB_XCNT(j)  (256  + 64 * (j))
#define XB_XSUB(j)  (1280 + 64 * (j))
#define XB_XGEN(j)  (2304 + 64 * (j))
#define XB_TOP      3328
#define XB_TOPGEN   3392
#define XCD_BAR_WORDS 3456
#define XB_SPIN_CAP (1u << 18)

__device__ __forceinline__ unsigned xb_ld(unsigned* p)              { return __hip_atomic_load(p, __ATOMIC_RELAXED, __HIP_MEMORY_SCOPE_AGENT); }
__device__ __forceinline__ unsigned xb_add(unsigned* p, unsigned v) { return __hip_atomic_fetch_add(p, v, __ATOMIC_RELAXED, __HIP_MEMORY_SCOPE_AGENT); }
__device__ __forceinline__ unsigned xb_xcc_id() { return (unsigned)__builtin_amdgcn_s_getreg((3 << 11) | 20) & 0xFu; }
#define XB_SPIN(cond, bar) do { unsigned _sp = 0; while (cond) { __builtin_amdgcn_s_sleep(1); \
    if ((++_sp & 255u) == 0u) { if (xb_ld(&(bar)[XB_TMO])) break; if (_sp > XB_SPIN_CAP) { atomicAdd(&(bar)[XB_TMO], 1u); break; } } } } while (0)

struct XcdBarrier {
    unsigned* bar; unsigned x;
    volatile LAS unsigned* st;
};

__device__ __forceinline__ XcdBarrier xcd_barrier_post(unsigned* bar, volatile LAS unsigned* st) {
    XcdBarrier b; b.bar = bar; b.x = xb_xcc_id(); b.st = st;
    if (threadIdx.x == 0) (void)xb_add(&bar[XB_XCNT(b.x)], 1u);
    return b;
}
__device__ __forceinline__ void xcd_barrier_complete(unsigned* bar, unsigned x, unsigned& nloc, unsigned& nx) {
    const unsigned G = gridDim.x * gridDim.y * gridDim.z;
    unsigned sum, cnt, mine, sp = 0u;
    for (;;) {
        sum = 0u; cnt = 0u; mine = 0u;
#pragma unroll
        for (unsigned j = 0; j < 16; ++j) { const unsigned c = xb_ld(&bar[XB_XCNT(j)]); sum += c; cnt += (c > 0u) ? 1u : 0u; mine = (j == x) ? c : mine; }
        if (sum == G) break;
        __builtin_amdgcn_s_sleep(1);
        if ((++sp & 255u) == 0u) { if (xb_ld(&bar[XB_TMO])) break; if (sp > XB_SPIN_CAP) { atomicAdd(&bar[XB_TMO], 1u); break; } }
    }
    nloc = mine > 0u ? mine : 1u; nx = cnt > 0u ? cnt : 1u;
}

__device__ __forceinline__ void xcd_barrier(const XcdBarrier& b) {
    asm volatile("s_waitcnt vmcnt(0)" ::: "memory");
    __syncthreads();
    if (threadIdx.x == 0) {
        unsigned* bar = b.bar;
        __builtin_amdgcn_s_waitcnt(0);
        unsigned nloc = b.st[0], nx = b.st[1];
        if (nloc == 0u) { xcd_barrier_complete(bar, b.x, nloc, nx); b.st[0] = nloc; b.st[1] = nx; }
        const unsigned old = xb_add(&bar[XB_XSUB(b.x)], 1u);
        const unsigned gen = old / nloc;
        if (old + 1u == (gen + 1u) * nloc) {
            __builtin_amdgcn_fence(__ATOMIC_RELEASE, "agent");
            asm volatile("s_waitcnt vmcnt(0)" ::: "memory");
            const unsigned og = xb_add(&bar[XB_TOP], 1u);
            const unsigned tg = og / nx;
            if (og + 1u == (tg + 1u) * nx) xb_add(&bar[XB_TOPGEN], 1u);
            else XB_SPIN(xb_ld(&bar[XB_TOPGEN]) == tg, bar);
            __builtin_amdgcn_fence(__ATOMIC_ACQUIRE, "agent");
            xb_add(&bar[XB_XGEN(b.x)], 1u);
            asm volatile("s_waitcnt vmcnt(0)" ::: "memory");
        } else {
            XB_SPIN(xb_ld(&bar[XB_XGEN(b.x)]) == gen, bar);
            __builtin_amdgcn_fence(__ATOMIC_ACQUIRE, "agent");
            asm volatile("s_waitcnt vmcnt(0)" ::: "memory");
        }
    }
    __syncthreads();
}

__global__ void __launch_bounds__(NTHR, 2) fwd_megakernel(Args A) {
    extern __shared__ __attribute__((aligned(16))) unsigned char lds_raw[];
    LAS unsigned char* lds = (LAS unsigned char*)lds_raw;
    const int tid = threadIdx.x, lane = tid & 63, wave = __builtin_amdgcn_readfirstlane(tid >> 6);
    const int G = gridDim.x, blk = blockIdx.x;
    const int gw = blk * NWAVES + wave, NGW = G * NWAVES;
    unsigned char* ws = A.ws;
    for (int u = tid; u < (LDS_BYTES - LDS_CTL_OFF) / 4; u += NTHR) ((LAS unsigned*)(lds + LDS_CTL_OFF))[u] = 0u;
    __syncthreads();
    XcdBarrier bar = xcd_barrier_post((unsigned*)(ws + WS_CTL), (volatile LAS unsigned*)(lds + MISC_OFF) + 8);

#ifndef PHMASK
#define PHMASK 0x3ff
#endif
#define PH(k) ((PHMASK >> (k)) & 1)
#ifndef DUPMASK
#define DUPMASK 0
#endif
#define REP(k) for (int rep_ = 0; rep_ < 1 + ((DUPMASK >> (k)) & 1); ++rep_)
    REP(0) if (PH(0)) p0_prologue(A, lds, gw, NGW, tid, lane, wave);
    xcd_barrier(bar);
    if (PH(1)) mod_final(A, blk, tid);
    if (PH(1)) norm_mod<true, false>(A, A.x, A.norm_g, 0 * DM, 1 * DM, (bf16*)(ws + WS_H), blk, wave, lane);
    xcd_barrier(bar);
    if (PH(2)) { pg8::Gemm g{(const pg8::bf16_t*)(ws + WS_H), (const pg8::bf16_t*)(ws + WS_WIN), TOK, NPROJ, DM}; pg8::StaticOrder S; S.init(TOK, NPROJ, G, blk);
      pg8::EpiBf16<0> E{(pg8::bf16_t*)(ws + WS_PROJ), NPROJ, nullptr, 0, 0, 1.f};
      pg8::gemm_phase<pg8::EpiBf16<0>, pg8::StaticOrder, true, true>(lds, g, S, E);
    }
    xcd_barrier(bar);
    REP(10) for (int u = blk; u < 128; u += G) cmp_unit(A, lds, u, tid, wave, lane);
    REP(11) for (int u = blk; u < 512; u += G) conv_unit(A, lds, u, tid, wave, lane);
    REP(12) for (int u = blk; u < 256; u += G) knorm_item(A, u, wave, lane);
    xcd_barrier(bar);
    REP(4) if (PH(4)) for (int u = blk; u < 256; u += G) { const int bg = u >> 4, s = u & 15;
        attn_unit(A, lds, bg >> 1, bg & 1, 31 - s, tid, wave, lane);
        attn_unit(A, lds, bg >> 1, bg & 1, s, tid, wave, lane); }
    for (int u = blk; u < 256; u += G) { const int bg = u >> 4, s = u & 15;
        const int cnt = s == 0 ? 6 : s < 3 ? 4 : s < 6 ? 3 : s < 8 ? 2 : s < 13 ? 1 : 0;
        const int off = s == 0 ? 0 : s < 3 ? 6 + 4 * (s - 1) : s < 6 ? 14 + 3 * (s - 3) : s < 8 ? 23 + 2 * (s - 6) : 27 + (s - 8);
        for (int k = 0; k < cnt; ++k) tab_convert_item(A, (bg * 8 + wave) * 32 + off + k, lane); }
    xcd_barrier(bar);
    if (PH(5)) { pg8::Gemm g{(const pg8::bf16_t*)(ws + WS_MIX), (const pg8::bf16_t*)(ws + WS_WOUT), TOK, DM, DM}; pg8::StaticOrder S; S.init(TOK, DM, G, blk);
      pg8::EpiResGate E{A.x, A.out, DM, (const float*)(ws + WS_MOD) + 2 * DM, NMOD, SEQ};
      pg8::gemm_phase<pg8::EpiResGate, pg8::StaticOrder, true, true>(lds, g, S, E); }
    xcd_barrier(bar);
    if (PH(6)) norm_mod<false, true>(A, A.out, A.norm_g + DM, 3 * DM, 4 * DM, (bf16*)(ws + WS_H), blk, wave, lane);
    xcd_barrier(bar);
    if (PH(7)) { pg8::Gemm g{(const pg8::bf16_t*)(ws + WS_H), (const pg8::bf16_t*)(ws + WS_WQ), TOK, NQP, DM}; pg8::StaticOrder S; S.init(TOK, NQP, G, blk);
      pg8::EpiBf16<0> E{(pg8::bf16_t*)(ws + WS_QP), NQP, nullptr, 0, 0, 1.f};
      pg8::gemm_phase<pg8::EpiBf16<0>, pg8::StaticOrder, true, true>(lds, g, S, E); }
    xcd_barrier(bar);
    REP(8) if (PH(8)) { int hcur = -1;
        for (int u = blk; u < 8 * (TOK / 256); u += G) { const int h = u & 7, tb = u >> 3;
            if (h != hcur) { __syncthreads(); peer_stage_subkeys(A, lds, h, tid); hcur = h; }
            peer_topk_unit(A, lds, h, tb, wave, lane); } }
    xcd_barrier(bar);
    REP(13) for (int wgi = gw; wgi < TOK / 8; wgi += NGW) peer_order_wave(A, lds, wgi, wave, lane);
    xcd_barrier(bar);
    REP(9) if (PH(9)) for (int wgi = gw; wgi < TOK / 8; wgi += NGW) peer_gather_wave(A, lds, wgi, wave, lane, rep_ == ((DUPMASK >> 9) & 1));
}

extern "C" void kernel_launch(void* const* d_in, const int* in_sizes, int n_in, void* d_out, int out_size, void* d_ws, size_t ws_size, hipStream_t stream) {
    static int grid = 0;
    if (grid == 0) {
        if (n_in != 20 || out_size != TOK * DM || ws_size < WS_CTL + CTL_ZERO_BYTES) { fprintf(stderr, "kernel_launch: unexpected shapes (n_in %d, out %d, ws %zu)\n", n_in, out_size, ws_size); grid = -1; return; }
        int dev = 0, cus = 0, per_cu = 0;
        hipGetDevice(&dev); hipDeviceGetAttribute(&cus, hipDeviceAttributeMultiprocessorCount, dev);
        hipFuncSetAttribute((const void*)fwd_megakernel, hipFuncAttributeMaxDynamicSharedMemorySize, LDS_BYTES);
        hipOccupancyMaxActiveBlocksPerMultiprocessor(&per_cu, (const void*)fwd_megakernel, NTHR, LDS_BYTES);
        if (per_cu < 1) { fprintf(stderr, "kernel_launch: occupancy query says %d blocks/CU\n", per_cu); per_cu = 1; }
        (void)hipGetLastError();
        grid = cus * 1;
        fprintf(stderr, "kernel_launch: cus %d per_cu %d grid %d\n", cus, per_cu, grid);
    }
    if (grid < 0) return;
    Args a{};
    const float** p = (const float**)&a;
    for (int i = 0; i < 20; ++i) p[i] = (const float*)d_in[i];
    a.out = (float*)d_out; a.ws = (unsigned char*)d_ws;
    if (hipMemsetAsync((char*)d_ws + WS_CTL, 0, CTL_ZERO_BYTES, stream) != hipSuccess) { fprintf(stderr, "kernel_launch: memset failed\n"); return; }
    hipLaunchKernelGGL(fwd_megakernel, dim3(grid), dim3(NTHR), LDS_BYTES, stream, a);
    const hipError_t e = hipPeekAtLastError();
    if (e != hipSuccess) fprintf(stderr, "launch failed: %s (grid %d)\n", hipGetErrorName(e), grid);
}
```

```cpp
#include <hip/hip_runtime.h>
#include <cstdio>
#include <cstdint>
namespace pg8 {
#define PG8_LAS __attribute__((address_space(3)))
typedef unsigned short bf16_t;
typedef short bf16x8 __attribute__((ext_vector_type(8)));
typedef float f32x4 __attribute__((ext_vector_type(4)));
typedef unsigned u32x4 __attribute__((ext_vector_type(4)));
constexpr int BM = 256, BK = 64, HALF = 128, HTB = HALF * BK * 2  , STAGE_BYTES = 8 * HTB, NXCD = 8, WGM = 8;

__host__ __device__ __forceinline__ int lds_byte(int r, int c) { const int st = (r >> 4) * 2 + (c >> 5), rr = r & 15, cc = c & 31, ob = rr * 64 + cc * 2; return st * 1024 + (ob ^ (((ob >> 9) & 1) << 5)); }
__host__ __device__ __forceinline__ void stage_rc(int b, int& R, int& C) { const int st = b / 1024, sb = b % 1024, swz = sb ^ (((sb >> 9) & 1) << 5); R = (st >> 1) * 16 + swz / 64; C = (st & 1) * 32 + (swz % 64) / 2; }
__host__ __device__ __forceinline__ int perm32(int rho) { const int n = rho >> 4, i = rho & 15; return 8 * (i >> 2) + 4 * n + (i & 3); }

struct Unit { int pm, pn; };
struct Gemm { const bf16_t* A; const bf16_t* Bt; int M, N, K; };

struct StaticOrder {
    int nM, nN, nwg, G, c;
    __host__ __device__ void init(int M, int N, int G_, int c_) { nM = M / BM; nN = N / BM; nwg = nM * nN; G = G_; c = c_; }
    __host__ __device__ bool next(int i, Unit& u) const {
        const long L = (long)i * G + c; if (L >= nwg) return false;
        int wgid = (int)L; { const int q = nwg / NXCD, r = nwg % NXCD, xcd = wgid % NXCD, off = wgid / NXCD; wgid = (xcd < r ? xcd * (q + 1) : r * (q + 1) + (xcd - r) * q) + off; }
        const int nig = WGM * nN, gid = wgid / nig, fm = gid * WGM, gsz = (nM - fm) < WGM ? (nM - fm) : WGM;
        u.pm = fm + ((wgid % nig) % gsz); u.pn = (wgid % nig) / gsz; return true;
    }
    __device__ __forceinline__ void a_ready(const Unit&) const {}
    __device__ __forceinline__ void done(const Unit&) const {}
};

__device__ __forceinline__ unsigned cvt_pk_bf16(float lo, float hi) { unsigned r; asm volatile("v_cvt_pk_bf16_f32 %0, %1, %2" : "=v"(r) : "v"(lo), "v"(hi)); return r; }
typedef float f32x2 __attribute__((ext_vector_type(2)));
__device__ __forceinline__ f32x2 gelu_pk(f32x2 v) {
    const f32x2 av = __builtin_elementwise_abs(v), d = av * 0.2316418882f + 1.0f;
    f32x2 t; t.x = __builtin_amdgcn_rcpf(d.x); t.y = __builtin_amdgcn_rcpf(d.y);
    f32x2 q = t * 0.5307027145f + (-0.7265760135f); q = q * t + 0.7107068705f; q = q * t + (-0.142248368f); q = q * t + 0.127414796f; q = q * t;
    const f32x2 s = (v * v) * (-0.72134752044f);
    f32x2 e; e.x = __builtin_amdgcn_exp2f(s.x); e.y = __builtin_amdgcn_exp2f(s.y);
    const f32x2 m = v * (q * e), r = v - m;
    f32x2 o; o.x = v.x < 0.f ? m.x : r.x; o.y = v.y < 0.f ? m.y : r.y; return o;
}

template <int ACT  > struct EpiBf16 {
    static constexpr bool PERM = true, AFTER_DRAIN = false; static_assert(ACT == 0 || ACT == 1, "EpiBf16: ACT is 0 (none) or 1 (gelu_pk)");
    bf16_t* O; int ldc; const float* bias; int split_cols; size_t split_stride; float scale0;
    __device__ __forceinline__ void operator()(const f32x4 (&acc)[2][2][4][2], const Unit& u, int wr, int wc, int fr, int fq) const {
        const int row0 = u.pm * BM + wr * 64 + fr; int colt = u.pn * BM; bf16_t* base = O;
        float sc = 1.f; if (split_cols) { const int t = colt / split_cols; base += (size_t)t * split_stride; colt -= t * split_cols; if (t == 0) sc = scale0; }
        const int col0 = colt + wc * 32 + 8 * fq, bcol0 = u.pn * BM + wc * 32 + 8 * fq;
        f32x4 bv[2][2];
#pragma unroll
        for (int bj = 0; bj < 2; ++bj)
#pragma unroll
            for (int n = 0; n < 2; ++n) bv[bj][n] = bias ? *(const f32x4*)(bias + bcol0 + bj * HALF + 4 * n) : (f32x4){0.f, 0.f, 0.f, 0.f};
#pragma unroll
        for (int ai = 0; ai < 2; ++ai)
#pragma unroll
            for (int m = 0; m < 4; ++m) { bf16_t* rowp = base + (size_t)(row0 + ai * HALF + m * 16) * ldc + col0;
#pragma unroll
                for (int bj = 0; bj < 2; ++bj) { f32x4 v0 = acc[ai][bj][m][0] + bv[bj][0], v1 = acc[ai][bj][m][1] + bv[bj][1];
                    if (ACT == 1) { f32x2 a = gelu_pk((f32x2){v0[0], v0[1]}), b = gelu_pk((f32x2){v0[2], v0[3]}), c = gelu_pk((f32x2){v1[0], v1[1]}), d = gelu_pk((f32x2){v1[2], v1[3]});
                        v0 = (f32x4){a.x, a.y, b.x, b.y}; v1 = (f32x4){c.x, c.y, d.x, d.y}; }
                    v0 = v0 * sc; v1 = v1 * sc; u32x4 w; w.x = cvt_pk_bf16(v0[0], v0[1]); w.y = cvt_pk_bf16(v0[2], v0[3]); w.z = cvt_pk_bf16(v1[0], v1[1]); w.w = cvt_pk_bf16(v1[2], v1[3]);
                    *(u32x4*)(rowp + bj * HALF) = w; } }
    }
};
struct EpiResGate {
    static constexpr bool PERM = false, AFTER_DRAIN = false;
    const float* base; float* out; int ldc; const float* gate; int gate_ld; int rows_per_batch;
    __device__ __forceinline__ void operator()(const f32x4 (&acc)[2][2][4][2], const Unit& u, int wr, int wc, int fr, int fq) const {
        const int col0 = u.pn * BM + wc * 32 + 4 * fq;
        const int b = (u.pm * BM) / rows_per_batch;
        f32x4 gv[2][2];
#pragma unroll
        for (int bj = 0; bj < 2; ++bj)
#pragma unroll
            for (int n = 0; n < 2; ++n) gv[bj][n] = *(const f32x4*)(gate + (size_t)b * gate_ld + col0 + bj * HALF + n * 16);
#pragma unroll
        for (int ai = 0; ai < 2; ++ai)
#pragma unroll
            for (int m = 0; m < 4; ++m) { const size_t off = (size_t)(u.pm * BM + ai * HALF + wr * 64 + m * 16 + fr) * ldc + col0;
#pragma unroll
                for (int bj = 0; bj < 2; ++bj)
#pragma unroll
                    for (int n = 0; n < 2; ++n) { const f32x4 bs = *(const f32x4*)(base + off + bj * HALF + n * 16);
                        *(f32x4*)(out + off + bj * HALF + n * 16) = bs + gv[bj][n] * acc[ai][bj][m][n]; } }
    }
};
template <class Epi, class Sched, bool ALIGN_EPI = false, bool SP2 = false>
__device__ __forceinline__ void gemm_phase(PG8_LAS unsigned char* lds, const Gemm g, const Sched& S, const Epi& E) {
    const int tid = threadIdx.x, wid = __builtin_amdgcn_readfirstlane(tid >> 6), lane = tid & 63, wr = wid >> 2, wc = wid & 3, fr = lane & 15, fq = lane >> 4;
    const int K = g.K, nt = K / BK;
    unsigned voffA[2], voffB[2];
#pragma unroll
    for (int i = 0; i < 2; ++i) { int R, C; stage_rc(tid * 16 + i * 8192, R, C); const int Rb = Epi::PERM ? ((R & ~31) + perm32(R & 31)) : R;
        voffA[i] = (unsigned)(R * K + C) * 2u; voffB[i] = (unsigned)(Rb * K + C) * 2u; }
    const size_t kstep = (size_t)(BK * 2);
    const size_t hstep = (size_t)HALF * K * 2;
    const size_t tstep = 2 * hstep;
    const unsigned ldsw = (unsigned)wid * 1024u;
    const int aoff = lds_byte(wr * 64 + fr, fq * 8), boff = lds_byte(wc * 32 + fr, fq * 8);
#define PG8_SA(b, h) (((b) * 2 + (h)) * HTB)
#define PG8_SB(b, h) ((4 + (b) * 2 + (h)) * HTB)
#define PG8_STAGE(bufoff, gbase, voff) do { _Pragma("unroll") for (int _i = 0; _i < 2; ++_i) \
        __builtin_amdgcn_global_load_lds((const unsigned*)((const char*)(gbase) + (voff)[_i]), (PG8_LAS unsigned*)(lds + (bufoff) + ldsw + _i * 8192), 16, 0, 0); } while (0)
#define PG8_LDA(dst, b, h) do { _Pragma("unroll") for (int m = 0; m < 4; ++m) _Pragma("unroll") for (int k = 0; k < 2; ++k) dst[m][k] = *(const PG8_LAS bf16x8*)(lds + PG8_SA(b, h) + aoff + m * 2048 + k * 1024); } while (0)
#define PG8_LDB(dst, b, h) do { _Pragma("unroll") for (int n = 0; n < 2; ++n) _Pragma("unroll") for (int k = 0; k < 2; ++k) dst[n][k] = *(const PG8_LAS bf16x8*)(lds + PG8_SB(b, h) + boff + n * 2048 + k * 1024); } while (0)
#define PG8_MMA(ai, bj, At, Bt) do { __builtin_amdgcn_s_setprio(1); _Pragma("unroll") for (int m = 0; m < 4; ++m) _Pragma("unroll") for (int n = 0; n < 2; ++n) _Pragma("unroll") for (int k = 0; k < 2; ++k) \
        acc[ai][bj][m][n] = __builtin_amdgcn_mfma_f32_16x16x32_bf16(Bt[n][k], At[m][k], acc[ai][bj][m][n], 0, 0, 0); __builtin_amdgcn_s_setprio(0); } while (0)
#define PG8_WAIT_V(n) asm volatile("s_waitcnt vmcnt(" #n ")" ::: "memory")
#define PG8_WAIT_L(n) asm volatile("s_waitcnt lgkmcnt(" #n ")" ::: "memory")
#define PG8_BAR __builtin_amdgcn_s_barrier()
#define PG8_SCHED __builtin_amdgcn_sched_barrier(0)
    Unit cur, nxt; int ui = 0;
    if (!S.next(0, cur)) return;
    f32x4 acc[2][2][4][2];
#pragma unroll
    for (int a = 0; a < 2; ++a)
#pragma unroll
        for (int b = 0; b < 2; ++b)
#pragma unroll
            for (int m = 0; m < 4; ++m)
#pragma unroll
                for (int n = 0; n < 2; ++n) acc[a][b][m][n] = (f32x4){0.f, 0.f, 0.f, 0.f};
    bf16x8 At[4][2], B0[2][2], B1[2][2];
    const char* cA = (const char*)g.A + (size_t)cur.pm * tstep; const char* cB = (const char*)g.Bt + (size_t)cur.pn * tstep;
    S.a_ready(cur);
    if constexpr (SP2) {
        PG8_STAGE(PG8_SB(0, 0), cB, voffB); PG8_STAGE(PG8_SB(0, 1), cB + hstep, voffB); PG8_STAGE(PG8_SA(0, 0), cA, voffA); PG8_STAGE(PG8_SA(0, 1), cA + hstep, voffA);
        if (wr == 1) PG8_BAR;
        PG8_WAIT_V(2); PG8_BAR;
        PG8_STAGE(PG8_SB(1, 0), cB + kstep, voffB); PG8_STAGE(PG8_SA(1, 0), cA + kstep, voffA); PG8_STAGE(PG8_SB(1, 1), cB + hstep + kstep, voffB);
        PG8_WAIT_V(6); PG8_BAR;
    } else {
        PG8_STAGE(PG8_SB(0, 0), cB, voffB); PG8_STAGE(PG8_SA(0, 0), cA, voffA); PG8_STAGE(PG8_SB(0, 1), cB + hstep, voffB); PG8_STAGE(PG8_SA(0, 1), cA + hstep, voffA);
        if (wr == 1) PG8_BAR;
        PG8_WAIT_V(4); PG8_BAR;
        PG8_STAGE(PG8_SB(1, 0), cB + kstep, voffB); PG8_STAGE(PG8_SA(1, 0), cA + kstep, voffA); PG8_STAGE(PG8_SB(1, 1), cB + hstep + kstep, voffB);
        PG8_WAIT_V(6); PG8_BAR;
    }
    for (;;) {
        const bool has_next = S.next(ui + 1, nxt);
        const char* nA = has_next ? (const char*)g.A + (size_t)nxt.pm * tstep : cA; const char* nB = has_next ? (const char*)g.Bt + (size_t)nxt.pn * tstep : cB;
        for (int t = 0; t < nt; t += 2) {
            const bool last = (t == nt - 2);
            const char* a1 = cA + (size_t)(t + 1) * kstep;
            const char* a2 = last ? nA : cA + (size_t)(t + 2) * kstep; const char* b2 = last ? nB : cB + (size_t)(t + 2) * kstep;
            const char* a3 = a2 + kstep; const char* b3 = b2 + kstep;
            if (last && has_next) S.a_ready(nxt);
            if constexpr (SP2) {
            PG8_LDB(B0, 0, 0); PG8_LDB(B1, 0, 1); PG8_SCHED; PG8_LDA(At, 0, 0); PG8_STAGE(PG8_SA(1, 1), a1 + hstep, voffA);
            PG8_WAIT_V(8); PG8_WAIT_L(0); PG8_BAR; PG8_MMA(0, 0, At, B0); PG8_MMA(0, 1, At, B1); PG8_BAR; PG8_SCHED;
            PG8_LDA(At, 0, 1); PG8_STAGE(PG8_SB(0, 0), b2, voffB); PG8_STAGE(PG8_SB(0, 1), b2 + hstep, voffB); PG8_STAGE(PG8_SA(0, 0), a2, voffA);
            PG8_WAIT_V(8); PG8_WAIT_L(0); PG8_BAR; PG8_MMA(1, 0, At, B0); PG8_MMA(1, 1, At, B1); PG8_BAR; PG8_SCHED;
            PG8_LDB(B0, 1, 0); PG8_LDB(B1, 1, 1); PG8_SCHED; PG8_LDA(At, 1, 0); PG8_STAGE(PG8_SA(0, 1), a2 + hstep, voffA);
            PG8_WAIT_V(8); PG8_WAIT_L(0); PG8_BAR; PG8_MMA(0, 0, At, B0); PG8_MMA(0, 1, At, B1); PG8_BAR; PG8_SCHED;
            PG8_LDA(At, 1, 1); PG8_STAGE(PG8_SB(1, 0), b3, voffB); PG8_STAGE(PG8_SB(1, 1), b3 + hstep, voffB); PG8_STAGE(PG8_SA(1, 0), a3, voffA);
            PG8_WAIT_V(8); PG8_WAIT_L(0); PG8_BAR; PG8_MMA(1, 0, At, B0); PG8_MMA(1, 1, At, B1); PG8_BAR; PG8_SCHED;
            } else {
            PG8_LDB(B0, 0, 0); PG8_SCHED; PG8_LDA(At, 0, 0); PG8_STAGE(PG8_SA(1, 1), a1 + hstep, voffA);
            PG8_WAIT_L(8); PG8_BAR; PG8_WAIT_L(0); PG8_MMA(0, 0, At, B0); PG8_BAR; PG8_SCHED;
            PG8_LDB(B1, 0, 1); PG8_STAGE(PG8_SB(0, 0), b2, voffB);
            PG8_BAR; PG8_WAIT_L(0); PG8_MMA(0, 1, At, B1); PG8_BAR;
            PG8_LDA(At, 0, 1); PG8_STAGE(PG8_SA(0, 0), a2, voffA);
            PG8_BAR; PG8_WAIT_L(0); PG8_MMA(1, 0, At, B0); PG8_BAR; PG8_SCHED;
            PG8_STAGE(PG8_SB(0, 1), b2 + hstep, voffB);
            PG8_WAIT_V(6); PG8_BAR; PG8_MMA(1, 1, At, B1); PG8_BAR;
            PG8_LDB(B0, 1, 0); PG8_SCHED; PG8_LDA(At, 1, 0); PG8_STAGE(PG8_SA(0, 1), a2 + hstep, voffA);
            PG8_WAIT_L(8); PG8_BAR; PG8_WAIT_L(0); PG8_MMA(0, 0, At, B0); PG8_BAR; PG8_SCHED;
            PG8_LDB(B1, 1, 1); PG8_STAGE(PG8_SB(1, 0), b3, voffB);
            PG8_BAR; PG8_WAIT_L(0); PG8_MMA(0, 1, At, B1); PG8_BAR;
            PG8_LDA(At, 1, 1); PG8_STAGE(PG8_SA(1, 0), a3, voffA);
            PG8_BAR; PG8_WAIT_L(0); PG8_MMA(1, 0, At, B0); PG8_BAR; PG8_SCHED;
            PG8_STAGE(PG8_SB(1, 1), b3 + hstep, voffB);
            PG8_WAIT_V(6); PG8_BAR; PG8_MMA(1, 1, At, B1); PG8_BAR;
            }
        }
        if constexpr (ALIGN_EPI) { if (wr == 0) PG8_BAR; }
        if constexpr (!Epi::AFTER_DRAIN) { E(acc, cur, wr, wc, fr, fq); S.done(cur); }
        if (!has_next) break;
#pragma unroll
        for (int a = 0; a < 2; ++a)
#pragma unroll
            for (int b = 0; b < 2; ++b)
#pragma unroll
                for (int m = 0; m < 4; ++m)
#pragma unroll
                    for (int n = 0; n < 2; ++n) acc[a][b][m][n] = (f32x4){0.f, 0.f, 0.f, 0.f};
        cur = nxt; cA = nA; cB = nB; ++ui;
        if constexpr (ALIGN_EPI) { if (wr == 1) PG8_BAR; }
    }
    PG8_WAIT_V(0);
    if constexpr (!ALIGN_EPI) { if (wr == 0) PG8_BAR; }
    PG8_BAR;
    if constexpr (Epi::AFTER_DRAIN) { E.fused(acc, cur, wr, wc, fr, fq, lds, wid, lane); S.done(cur); }
#undef PG8_SA
#undef PG8_SB
#undef PG8_STAGE
#undef PG8_LDA
#undef PG8_LDB
#undef PG8_MMA
#undef PG8_WAIT_V
#undef PG8_WAIT_L
#undef PG8_BAR
#undef PG8_SCHED
}
}

#define LAS __attribute__((address_space(3)))
typedef unsigned short bf16;
typedef unsigned v4u __attribute__((ext_vector_type(4)));
typedef unsigned v2u __attribute__((ext_vector_type(2)));
typedef int v4i __attribute__((ext_vector_type(4)));
typedef int v2i __attribute__((ext_vector_type(2)));
typedef float f32x4 __attribute__((ext_vector_type(4)));
typedef float f32x2 __attribute__((ext_vector_type(2)));
typedef float f32x16 __attribute__((ext_vector_type(16)));
typedef short bf16x8 __attribute__((ext_vector_type(8)));
typedef short s16x4 __attribute__((ext_vector_type(4)));
typedef __bf16 bf16x2_t __attribute__((ext_vector_type(2)));

constexpr int NWAVES = 8, NTHR = 512;
constexpr int BATCH = 8, SEQ = 2048, DM = 1024, TOK = BATCH * SEQ;
constexpr int NPROJ = 2560, C_KV = 512, C_GLU = 1280, C_GATE = 2304, IN_COLS = 2328;
constexpr int NQP = 2048, NMOD = 6144;
constexpr float EPS = 1e-6f, LOG2E = 1.4426950408889634f;
constexpr int LDS_BYTES = 162816, LDS_CTL_OFF = 161792, PG_WSTRIDE = 20224;

constexpr size_t MiB = 1u << 20;
constexpr size_t WS_MODP = 0, WS_MOD = 3 * MiB, WS_BIASP = 3 * MiB + 256 * 1024, WS_SUBK = 3 * MiB + 512 * 1024;
constexpr size_t WS_WCK = 4 * MiB, WS_WCV = 4 * MiB + 256 * 1024, WS_KC = 4 * MiB + 512 * 1024, WS_VC = 4 * MiB + 768 * 1024;
constexpr size_t WS_WIN = 5 * MiB, WS_WOUT = 10 * MiB, WS_WQ = 12 * MiB;
constexpr size_t WS_KS = 16 * MiB, WS_VS = 20 * MiB, WS_KW = 24 * MiB, WS_VW = 28 * MiB;
constexpr size_t WS_ENTG = 16 * MiB;
constexpr size_t WS_H = 32 * MiB, WS_MIX = 64 * MiB, WS_PROJ = 96 * MiB, WS_QP = 96 * MiB;
constexpr size_t WS_U8 = 176 * MiB, WS_V8 = 192 * MiB, WS_SU = 208 * MiB, WS_SV = 208 * MiB + 65536, WS_SH = 208 * MiB + 131072, WS_H8 = 224 * MiB, WS_END = 240 * MiB;
constexpr size_t WS_META = 64 * MiB, META_STRIDE = 12288;

struct Args {
    const float *x, *c, *w_ada, *b_ada, *norm_g, *w_in, *w_out, *pe_k, *pe_v, *w_ck, *w_cv, *qkg, *dw_w, *dw_b, *ln_g, *ln_b, *wq, *subk, *pu, *pv;
    float* out; unsigned char* ws;
};

__device__ __forceinline__ float bf2f(unsigned short v) { return __uint_as_float((unsigned)v << 16); }
__device__ __forceinline__ float bflo(unsigned v) { return __uint_as_float(v << 16); }
__device__ __forceinline__ float bfhi(unsigned v) { return __uint_as_float(v & 0xffff0000u); }
__device__ __forceinline__ unsigned cvtpk(float lo, float hi) { f32x2 v = {lo, hi}; bf16x2_t b = __builtin_convertvector(v, bf16x2_t); return __builtin_bit_cast(unsigned, b); }
__device__ __forceinline__ float wave_sum(float v) {
#pragma unroll
    for (int o = 1; o < 64; o <<= 1) v += __shfl_xor(v, o);
    return v;
}
__device__ __forceinline__ float swap32(float v) { return __shfl_xor(v, 32); }
__device__ __forceinline__ float pairmax32(float v) { const auto rr = __builtin_amdgcn_permlane32_swap(__float_as_uint(v), __float_as_uint(v), false, false); return fmaxf(__uint_as_float(rr[0]), __uint_as_float(rr[1])); }
__device__ __forceinline__ float pairsum32(float v) { const auto rr = __builtin_amdgcn_permlane32_swap(__float_as_uint(v), __float_as_uint(v), false, false); return __uint_as_float(rr[0]) + __uint_as_float(rr[1]); }
__device__ __forceinline__ int crow(int r, int hi) { return (r & 3) + 8 * (r >> 2) + 4 * hi; }
__device__ __forceinline__ f32x16 mfma32(bf16x8 a, bf16x8 b, f32x16 c) { return __builtin_amdgcn_mfma_f32_32x32x16_bf16(a, b, c, 0, 0, 0); }
__device__ __forceinline__ float fast_exp2(float x) { return __builtin_amdgcn_exp2f(x); }
__device__ __forceinline__ float sigmoidf_(float x) { return __builtin_amdgcn_rcpf(1.0f + __expf(-x)); }

__device__ __forceinline__ void transpose_item(const float* W, int ldw, int col0, int ncols, bf16* WT, int K, int drow0, int k0, LAS float* scr, int lane) {
    const int n = lane & 31;
#pragma unroll 16
    for (int i = 0; i < 32; ++i) { const int kk = 2 * i + (lane >> 5); scr[kk * 33 + n] = (n < ncols) ? W[(size_t)(k0 + kk) * ldw + col0 + n] : 0.f; }
    asm volatile("s_waitcnt lgkmcnt(0)" ::: "memory");
    const int c = lane & 7;
#pragma unroll
    for (int j = 0; j < 4; ++j) { const int nn = (lane >> 3) + 8 * j; const LAS float* s = scr + (8 * c) * 33 + nn;
        v4u o; o.x = cvtpk(s[0 * 33], s[1 * 33]); o.y = cvtpk(s[2 * 33], s[3 * 33]); o.z = cvtpk(s[4 * 33], s[5 * 33]); o.w = cvtpk(s[6 * 33], s[7 * 33]);
        *(v4u*)(WT + (size_t)(drow0 + nn) * K + k0 + 8 * c) = o; }
    asm volatile("s_waitcnt lgkmcnt(0)" ::: "memory");
}

__device__ __forceinline__ void tab_convert_item(const Args& A, int it, int lane) {
    unsigned char* ws = A.ws;
            const int which = it >> 11, r0 = (it & 2047) * 8;
    for (int rb = 0; rb < 8; rb += 4) {
        f32x4 v[4][4]; float am[4];
#pragma unroll
        for (int rr = 0; rr < 4; ++rr) { const float* src = (which ? A.pv : A.pu) + (size_t)(r0 + rb + rr) * DM + 4 * lane;
#pragma unroll
            for (int j = 0; j < 4; ++j) v[rr][j] = *(const f32x4*)(src + 256 * j); }
#pragma unroll
        for (int rr = 0; rr < 4; ++rr) { float m_ = 0.f;
#pragma unroll
            for (int j = 0; j < 4; ++j) m_ = fmaxf(fmaxf(m_, fmaxf(fabsf(v[rr][j][0]), fabsf(v[rr][j][1]))), fmaxf(fabsf(v[rr][j][2]), fabsf(v[rr][j][3])));
            am[rr] = m_; }
#pragma unroll
        for (int o = 1; o < 64; o <<= 1) {
#pragma unroll
            for (int rr = 0; rr < 4; ++rr) am[rr] = fmaxf(am[rr], __shfl_xor(am[rr], o)); }
#pragma unroll
        for (int rr = 0; rr < 4; ++rr) { const int rowi = r0 + rb + rr; const float sc = am[rr] > 0.f ? am[rr] * (which ? (1.0f / 240.0f) : (1.0f / 127.0f)) : 1.0f, isc = 1.0f / sc;
#pragma unroll
            for (int j = 0; j < 4; ++j) { unsigned w = 0u;
                if (which) { int p = __builtin_amdgcn_cvt_pk_fp8_f32(v[rr][j][0] * isc, v[rr][j][1] * isc, 0, false); p = __builtin_amdgcn_cvt_pk_fp8_f32(v[rr][j][2] * isc, v[rr][j][3] * isc, p, true); w = (unsigned)p; }
                else {
#pragma unroll
                    for (int i = 0; i < 4; ++i) { const int q = (int)rintf(v[rr][j][i] * isc); w |= ((unsigned)q & 0xFFu) << (8 * i); } }
                *(unsigned*)(ws + (which ? WS_V8 : WS_U8) + (size_t)rowi * DM + 256 * j + 4 * lane) = w; }
            if (lane == 0) ((float*)(ws + (which ? WS_SV : WS_SU)))[rowi] = sc; } }
}

__device__ __forceinline__ void p0_prologue(const Args& A, LAS unsigned char* lds, int gw, int NGW, int tid, int lane, int wave, bool part_b) {
    unsigned char* ws = A.ws;
    LAS float* SILU = (LAS float*)(lds + 73728);
    if (!part_b) { for (int i = tid; i < BATCH * DM; i += NTHR) { const float v = A.c[i]; SILU[i] = v / (1.0f + __expf(-v)); }
        __syncthreads(); }
    LAS float* scr = (LAS float*)(lds + wave * 8704);
    constexpr int NI_MODP = 192 * 16, NI_T1 = 640, NI_T2 = 512, NI_T3 = 16, NI_TO = 512, NI_TQ = 1024, NI_TCK = 64, NI_TCV = 64, NI_ZP = 28, NI_SK = 128, NI_BP = 64;
    constexpr int NIT = NI_MODP + NI_T1 + NI_T2 + NI_T3 + NI_TO + NI_TQ + NI_TCK + NI_TCV + NI_ZP + NI_SK + NI_BP;
    const int it_lo = part_b ? NI_MODP : 0, it_hi = part_b ? NIT : NI_MODP;
    for (int it0 = gw + it_lo; it0 < it_hi; it0 += NGW) {
        int it = it0;
        if (it < NI_MODP) {
            const int cb = it % 192, ks = it / 192, col = cb * 32 + (lane & 31), kpar = lane >> 5;
            float acc[8];
#pragma unroll
            for (int b = 0; b < 8; ++b) acc[b] = 0.f;
#pragma unroll 16
            for (int i = 0; i < 32; ++i) { const int k = ks * 64 + 2 * i + kpar; const float w = A.w_ada[(size_t)k * NMOD + col];
#pragma unroll
                for (int b = 0; b < 8; ++b) acc[b] += SILU[b * DM + k] * w; }
            float* MODP = (float*)(ws + WS_MODP);
#pragma unroll
            for (int b = 0; b < 8; ++b) { const float s = acc[b] + __shfl_xor(acc[b], 32); if (lane < 32) MODP[(size_t)(ks * 8 + b) * NMOD + col] = s; }
            continue;
        } it -= NI_MODP;
        if (it < NI_T1) { transpose_item(A.w_in, IN_COLS, (it % 40) * 32, 32, (bf16*)(ws + WS_WIN), DM, (it % 40) * 32, (it / 40) * 64, scr, lane); continue; } it -= NI_T1;
        if (it < NI_T2) { transpose_item(A.w_in, IN_COLS, 1304 + (it % 32) * 32, 32, (bf16*)(ws + WS_WIN), DM, C_GLU + (it % 32) * 32, (it / 32) * 64, scr, lane); continue; } it -= NI_T2;
        if (it < NI_T3) { transpose_item(A.w_in, IN_COLS, 1280, 24, (bf16*)(ws + WS_WIN), DM, C_GATE, it * 64, scr, lane); continue; } it -= NI_T3;
        if (it < NI_TO) { transpose_item(A.w_out, DM, (it % 32) * 32, 32, (bf16*)(ws + WS_WOUT), DM, (it % 32) * 32, (it / 32) * 64, scr, lane); continue; } it -= NI_TO;
        if (it < NI_TQ) { transpose_item(A.wq, NQP, (it % 64) * 32, 32, (bf16*)(ws + WS_WQ), DM, (it % 64) * 32, (it / 64) * 64, scr, lane); continue; } it -= NI_TQ;
        if (it < NI_TCK) { transpose_item(A.w_ck, 64, (it & 1) * 32, 32, (bf16*)(ws + WS_WCK), 2048, (it & 1) * 32, (it >> 1) * 64, scr, lane); continue; } it -= NI_TCK;
        if (it < NI_TCV) { transpose_item(A.w_cv, 64, (it & 1) * 32, 32, (bf16*)(ws + WS_WCV), 2048, (it & 1) * 32, (it >> 1) * 64, scr, lane); continue; } it -= NI_TCV;
        if (it < NI_ZP) { bf16* base = (bf16*)(ws + WS_WIN) + (size_t)(2336 + it * 8) * DM;
#pragma unroll 4
            for (int i = 0; i < 16; ++i) *(v4u*)(base + i * 512 + lane * 8) = (v4u){0u, 0u, 0u, 0u};
            continue; } it -= NI_ZP;
        if (it < NI_SK) { const float* src = A.subk + (size_t)it * 2048; bf16* dst = (bf16*)(ws + WS_SUBK) + (size_t)it * 2048;
#pragma unroll
            for (int i = 0; i < 4; ++i) { const f32x4 a = *(const f32x4*)(src + i * 512 + lane * 8), b = *(const f32x4*)(src + i * 512 + lane * 8 + 4);
                v4u o; o.x = cvtpk(a[0], a[1]); o.y = cvtpk(a[2], a[3]); o.z = cvtpk(b[0], b[1]); o.w = cvtpk(b[2], b[3]); *(v4u*)(dst + i * 512 + lane * 8) = o; }
            continue; } it -= NI_SK;
        { const int kv = it >> 5, l = it & 31; const float* pe = (kv ? A.pe_v : A.pe_k) + l * 64; const float* w = (kv ? A.w_cv : A.w_ck) + (size_t)l * 64 * 64;
            float s = 0.f;
#pragma unroll 32
            for (int d = 0; d < 64; ++d) s += pe[d] * w[d * 64 + lane];
            ((float*)(ws + WS_BIASP))[(kv * 32 + l) * 64 + lane] = s; }
    }
}

template <bool FROM_PARTIALS, bool Q8>
__device__ __forceinline__ void norm_mod(const Args& A, const float* X, const float* gvec, int sh_off, int sc_off, bf16* Hout, int blk, int wave, int lane) {
    const float* MODP = (const float*)(A.ws + WS_MODP); const float* MODF = (const float*)(A.ws + WS_MOD);
    for (int rb = blk; rb < TOK / 64; rb += gridDim.x) {
        const int b = rb >> 5;
        f32x4 ca[4], cb[4];
#pragma unroll
        for (int j = 0; j < 4; ++j) { const int col = 256 * j + 4 * lane; f32x4 sc, sh;
            if (FROM_PARTIALS) { sc = *(const f32x4*)(A.b_ada + sc_off + col); sh = *(const f32x4*)(A.b_ada + sh_off + col);
                for (int ks = 0; ks < 16; ++ks) { sc += *(const f32x4*)(MODP + (size_t)(ks * 8 + b) * NMOD + sc_off + col); sh += *(const f32x4*)(MODP + (size_t)(ks * 8 + b) * NMOD + sh_off + col); } }
            else { sc = *(const f32x4*)(MODF + b * NMOD + sc_off + col); sh = *(const f32x4*)(MODF + b * NMOD + sh_off + col); }
            const f32x4 g = *(const f32x4*)(gvec + col); ca[j] = g * (sc + 1.0f); cb[j] = sh; }
        for (int rr = 0; rr < 8; ++rr) { const int row = rb * 64 + wave * 8 + rr; const float* xr = X + (size_t)row * DM + 4 * lane;
            f32x4 v[4]; float ss = 0.f;
#pragma unroll
            for (int j = 0; j < 4; ++j) { v[j] = *(const f32x4*)(xr + 256 * j); ss += (v[j][0] * v[j][0] + v[j][1] * v[j][1]) + (v[j][2] * v[j][2] + v[j][3] * v[j][3]); }
            const float rstd = rsqrtf(wave_sum(ss) * (1.0f / DM) + EPS);
#pragma unroll
            for (int j = 0; j < 4; ++j) { const f32x4 o = v[j] * rstd * ca[j] + cb[j]; v[j] = o; v2u w; w.x = cvtpk(o[0], o[1]); w.y = cvtpk(o[2], o[3]); *(v2u*)(Hout + (size_t)row * DM + 256 * j + 4 * lane) = w; }
            if (Q8) { float am = 0.f;
#pragma unroll
                for (int j = 0; j < 4; ++j) am = fmaxf(fmaxf(am, fmaxf(fabsf(v[j][0]), fabsf(v[j][1]))), fmaxf(fabsf(v[j][2]), fabsf(v[j][3])));
#pragma unroll
                for (int o = 1; o < 64; o <<= 1) am = fmaxf(am, __shfl_xor(am, o));
                const float sc = am > 0.f ? am * (1.0f / 127.0f) : 1.0f, isc = 1.0f / sc;
#pragma unroll
                for (int j = 0; j < 4; ++j) { unsigned w = 0u;
#pragma unroll
                    for (int i = 0; i < 4; ++i) w |= ((unsigned)((int)rintf(v[j][i] * isc)) & 0xFFu) << (8 * i);
                    *(unsigned*)(A.ws + WS_H8 + (size_t)row * DM + 256 * j + 4 * lane) = w; }
                if (lane == 0) ((float*)(A.ws + WS_SH))[row] = sc; } }
    }
}
__device__ __forceinline__ void mod_final(const Args& A, int blk, int tid) {
    const float* MODP = (const float*)(A.ws + WS_MODP); float* MODF = (float*)(A.ws + WS_MOD);
    for (int idx = blk * NTHR + tid; idx < BATCH * NMOD; idx += gridDim.x * NTHR) { const int b = idx / NMOD, n = idx % NMOD; float s = A.b_ada[n];
        for (int ks = 0; ks < 16; ++ks) s += MODP[(size_t)(ks * 8 + b) * NMOD + n];
        MODF[idx] = s; }
}

__device__ __forceinline__ void knorm_item(const Args& A, int item, int wave, int lane) {
    const bf16* PROJ = (const bf16*)(A.ws + WS_PROJ);
    const int rowid = lane >> 3, chunk = lane & 7, kind = rowid >> 1, g = rowid & 1;
    bf16* dstb = (bf16*)(A.ws + (kind == 0 ? WS_KS : kind == 1 ? WS_VS : kind == 2 ? WS_KW : WS_VW));
    float gk[8];
#pragma unroll
    for (int i = 0; i < 8; ++i) gk[i] = A.qkg[(kind == 0 ? 128 : 192) + chunk * 8 + i];
    for (int rr = 0; rr < 8; ++rr) { const int tok = item * 64 + wave * 8 + rr, b = tok >> 11, s = tok & 2047;
        const v4u raw = *(const v4u*)(PROJ + (size_t)tok * NPROJ + 768 + rowid * 64 + chunk * 8);
        float v[8]; v[0] = bflo(raw.x); v[1] = bfhi(raw.x); v[2] = bflo(raw.y); v[3] = bfhi(raw.y); v[4] = bflo(raw.z); v[5] = bfhi(raw.z); v[6] = bflo(raw.w); v[7] = bfhi(raw.w);
        float ss = 0.f;
#pragma unroll
        for (int i = 0; i < 8; ++i) ss += v[i] * v[i];
        ss += __shfl_xor(ss, 1); ss += __shfl_xor(ss, 2); ss += __shfl_xor(ss, 4);
        v4u o = raw;
        if ((kind & 1) == 0) { const float rstd = rsqrtf(ss * (1.0f / 64.0f) + EPS);
#pragma unroll
            for (int i = 0; i < 8; ++i) v[i] = v[i] * rstd * gk[i];
            o.x = cvtpk(v[0], v[1]); o.y = cvtpk(v[2], v[3]); o.z = cvtpk(v[4], v[5]); o.w = cvtpk(v[6], v[7]); }
        *(v4u*)(dstb + ((size_t)(b * 2 + g) * SEQ + s) * 64 + chunk * 8) = o; }
}

__device__ __forceinline__ void cmp_unit(const Args& A, LAS unsigned char* lds, int u, int tid, int wave, int lane) {
    const bf16* PROJ = (const bf16*)(A.ws + WS_PROJ);
    const int b = u >> 4, g = (u >> 3) & 1, kv = (u >> 2) & 1, nq4 = u & 3;
    const int r32 = lane & 31, hi = lane >> 5, kq = wave;
    const int n = nq4 * 32 + r32, nn = n < 127 ? n : 126;
    const bf16* arow = PROJ + (size_t)(b * SEQ + 16 * nn) * NPROJ + C_KV + kv * 128 + g * 64;
    const bf16* wt = (const bf16*)(A.ws + (kv ? WS_WCV : WS_WCK));
    f32x16 acc0, acc1;
#pragma unroll
    for (int r = 0; r < 16; ++r) { acc0[r] = 0.f; acc1[r] = 0.f; }
#pragma unroll 8
    for (int ks = 0; ks < 16; ++ks) { const int k0 = kq * 256 + ks * 16, l = k0 >> 6, d0 = k0 & 63;
        const bf16x8 a = *(const bf16x8*)(arow + (size_t)l * NPROJ + d0 + 8 * hi);
        const bf16x8 b0 = *(const bf16x8*)(wt + (size_t)r32 * 2048 + k0 + 8 * hi);
        const bf16x8 b1 = *(const bf16x8*)(wt + (size_t)(32 + r32) * 2048 + k0 + 8 * hi);
        acc0 = mfma32(a, b0, acc0); acc1 = mfma32(a, b1, acc1); }
    LAS float* RED = (LAS float*)lds;
    LAS float* BIAS = (LAS float*)(lds + 65536);
#pragma unroll
    for (int r = 0; r < 16; ++r) { const int row = crow(r, hi); RED[(kq * 32 + row) * 64 + r32] = acc0[r]; RED[(kq * 32 + row) * 64 + 32 + r32] = acc1[r]; }
    if (tid < 64) { const float* BP = (const float*)(A.ws + WS_BIASP) + kv * 32 * 64; float s = 0.f; for (int l = 0; l < 32; ++l) s += BP[l * 64 + tid]; BIAS[tid] = s; }
    __syncthreads();
    { const int row = tid >> 4, e0 = (tid & 15) * 4;
        float v[4];
#pragma unroll
        for (int i = 0; i < 4; ++i) { float s = BIAS[e0 + i];
#pragma unroll
            for (int q = 0; q < 8; ++q) s += RED[(q * 32 + row) * 64 + e0 + i];
            v[i] = s; }
        if (kv == 0) { float ss = (v[0] * v[0] + v[1] * v[1]) + (v[2] * v[2] + v[3] * v[3]);
            ss += __shfl_xor(ss, 1); ss += __shfl_xor(ss, 2); ss += __shfl_xor(ss, 4); ss += __shfl_xor(ss, 8);
            const float rstd = rsqrtf(ss * (1.0f / 64.0f) + EPS);
#pragma unroll
            for (int i = 0; i < 4; ++i) v[i] = v[i] * rstd * A.qkg[64 + e0 + i]; }
        const int ng = nq4 * 32 + row;
        if (ng == 127) {
#pragma unroll
            for (int i = 0; i < 4; ++i) v[i] = 0.f; }
        v2u o; o.x = cvtpk(v[0], v[1]); o.y = cvtpk(v[2], v[3]);
        *(v2u*)((bf16*)(A.ws + (kv ? WS_VC : WS_KC)) + ((size_t)(b * 2 + g) * 128 + ng) * 64 + e0) = o; }
    __syncthreads();
}

__device__ __forceinline__ void conv_unit(const Args& A, LAS unsigned char* lds, int u, int tid, int wave, int lane) {
    const bf16* PROJ = (const bf16*)(A.ws + WS_PROJ); bf16* MIX = (bf16*)(A.ws + WS_MIX);
    const int b = u >> 6, t0 = (u & 63) * 32, c = tid;
    LAS float* U = (LAS float*)lds;
#pragma unroll 1
    for (int p0 = 0; p0 < 62 * 64; p0 += 4 * NTHR) {
        v4u av[4], bv[4];
#pragma unroll
        for (int q = 0; q < 4; ++q) { const int p = p0 + q * NTHR + tid, i = p >> 6, ch = (p & 63) * 8, ts = t0 - 30 + i;
            if (p < 62 * 64 && ts >= 0) { const bf16* pr = PROJ + (size_t)(b * SEQ + ts) * NPROJ + C_GLU + ch; av[q] = *(const v4u*)pr; bv[q] = *(const v4u*)(pr + 512); }
            else { av[q] = (v4u){0u, 0u, 0u, 0u}; bv[q] = (v4u){0u, 0u, 0u, 0u}; } }
#pragma unroll
        for (int q = 0; q < 4; ++q) { const int p = p0 + q * NTHR + tid, i = p >> 6, ch = (p & 63) * 8;
            if (p < 62 * 64) { f32x4 u0, u1;
                u0[0] = bflo(av[q].x) * sigmoidf_(bflo(bv[q].x)); u0[1] = bfhi(av[q].x) * sigmoidf_(bfhi(bv[q].x)); u0[2] = bflo(av[q].y) * sigmoidf_(bflo(bv[q].y)); u0[3] = bfhi(av[q].y) * sigmoidf_(bfhi(bv[q].y));
                u1[0] = bflo(av[q].z) * sigmoidf_(bflo(bv[q].z)); u1[1] = bfhi(av[q].z) * sigmoidf_(bfhi(bv[q].z)); u1[2] = bflo(av[q].w) * sigmoidf_(bflo(bv[q].w)); u1[3] = bfhi(av[q].w) * sigmoidf_(bfhi(bv[q].w));
                *(LAS f32x4*)(U + i * 512 + ch) = u0; *(LAS f32x4*)(U + i * 512 + ch + 4) = u1; } }
    }
    float w[31];
#pragma unroll
    for (int k = 0; k < 31; ++k) w[k] = A.dw_w[k * 512 + c];
    const float bias = A.dw_b[c];
    __syncthreads();
    float y[32];
#pragma unroll
    for (int t = 0; t < 32; ++t) y[t] = bias;
#pragma unroll
    for (int i = 0; i < 62; ++i) { const float uv = U[i * 512 + c];
#pragma unroll
        for (int t = 0; t < 32; ++t) if (i - t >= 0 && i - t <= 30) y[t] += uv * w[i - t]; }
    __syncthreads();
#pragma unroll
    for (int t = 0; t < 32; ++t) U[t * 512 + c] = y[t];
    __syncthreads();
    f32x4 lg0 = *(const f32x4*)(A.ln_g + 8 * lane), lg1 = *(const f32x4*)(A.ln_g + 8 * lane + 4), lb0 = *(const f32x4*)(A.ln_b + 8 * lane), lb1 = *(const f32x4*)(A.ln_b + 8 * lane + 4);
    for (int tt = 0; tt < 4; ++tt) { const int t = wave * 4 + tt;
        f32x4 a0 = *(const LAS f32x4*)(U + t * 512 + 8 * lane), a1 = *(const LAS f32x4*)(U + t * 512 + 8 * lane + 4);
        float s = (a0[0] + a0[1]) + (a0[2] + a0[3]) + (a1[0] + a1[1]) + (a1[2] + a1[3]);
        const float mu = wave_sum(s) * (1.0f / 512.0f);
        a0 = a0 - mu; a1 = a1 - mu;
        float q = (a0[0] * a0[0] + a0[1] * a0[1]) + (a0[2] * a0[2] + a0[3] * a0[3]) + (a1[0] * a1[0] + a1[1] * a1[1]) + (a1[2] * a1[2] + a1[3] * a1[3]);
        const float rstd = rsqrtf(wave_sum(q) * (1.0f / 512.0f) + EPS);
        a0 = a0 * rstd * lg0 + lb0; a1 = a1 * rstd * lg1 + lb1;
        float o[8];
#pragma unroll
        for (int i = 0; i < 4; ++i) { o[i] = a0[i] * sigmoidf_(a0[i]); o[4 + i] = a1[i] * sigmoidf_(a1[i]); }
        v4u ov; ov.x = cvtpk(o[0], o[1]); ov.y = cvtpk(o[2], o[3]); ov.z = cvtpk(o[4], o[5]); ov.w = cvtpk(o[6], o[7]);
        *(v4u*)(MIX + (size_t)(b * SEQ + t0 + t) * DM + 512 + 8 * lane) = ov; }
    __syncthreads();
}

constexpr int A_K0 = 0, A_K1 = 8192, A_V0 = 16384, A_V1 = 24576, A_WSF = 32768, A_IMP = 36864, A_IMPS = 70656, A_SELM = 79104, A_ANY = 79360;
constexpr float NEG_MASK = -1e30f, M_INIT = -1e20f;

__device__ __forceinline__ void stage_kv(LAS unsigned char* lds, int koff, int voff, const bf16* Ksrc, const bf16* Vsrc, int wave, int lane) {
    const v4u kx = *(const v4u*)(Ksrc + lane * 64 + wave * 8);
    const v4u vx = *(const v4u*)(Vsrc + (16 * (wave & 3) + (lane >> 2)) * 64 + (wave >> 2) * 32 + (lane & 3) * 8);
    *(LAS v4u*)(lds + koff + wave * 1024 + lane * 16) = kx;
    *(LAS v4u*)(lds + voff + wave * 1024 + lane * 16) = vx;
}
__device__ __forceinline__ void qkt_acc(f32x16& p0, f32x16& p1, const LAS unsigned char* kslot, const bf16x8 (&qr)[4], int r32, int hi) {
    const LAS unsigned char* kb = kslot + hi * 1024 + r32 * 16;
#pragma unroll
    for (int d0 = 0; d0 < 4; ++d0) { const bf16x8 b0 = *(const LAS bf16x8*)(kb + d0 * 2048), b1 = *(const LAS bf16x8*)(kb + d0 * 2048 + 512);
        p0 = mfma32(b0, qr[d0], p0); p1 = mfma32(b1, qr[d0], p1); }
}
__device__ __forceinline__ void qkt(f32x16& p0, f32x16& p1, const LAS unsigned char* kslot, const bf16x8 (&qr)[4], int r32, int hi) {
    const LAS unsigned char* kb = kslot + hi * 1024 + r32 * 16;
#pragma unroll
    for (int r = 0; r < 16; ++r) { p0[r] = 0.f; p1[r] = 0.f; }
#pragma unroll
    for (int d0 = 0; d0 < 4; ++d0) { const bf16x8 b0 = *(const LAS bf16x8*)(kb + d0 * 2048), b1 = *(const LAS bf16x8*)(kb + d0 * 2048 + 512);
        p0 = mfma32(b0, qr[d0], p0); p1 = mfma32(b1, qr[d0], p1); }
}
__device__ __forceinline__ s16x4 vtr(const LAS unsigned char* p) { return __builtin_bit_cast(s16x4, __builtin_amdgcn_ds_read_tr16_b64_v4i16((LAS s16x4*)p)); }
__device__ __forceinline__ void pv(f32x16 (&o)[2], const LAS unsigned char* vslot, const f32x16& p0, const f32x16& p1, int lane, int hi) {
    const LAS unsigned char* vp = vslot + ((lane >> 4) & 1) * 32 + (lane & 3) * 8 + (4 * hi + ((lane & 15) >> 2)) * 64;
    v4u pw[4];
#pragma unroll
    for (int i = 0; i < 4; ++i) { pw[0][i] = cvtpk(p0[2 * i], p0[2 * i + 1]); pw[1][i] = cvtpk(p0[8 + 2 * i], p0[9 + 2 * i]); pw[2][i] = cvtpk(p1[2 * i], p1[2 * i + 1]); pw[3][i] = cvtpk(p1[8 + 2 * i], p1[9 + 2 * i]); }
#pragma unroll
    for (int d0 = 0; d0 < 2; ++d0)
#pragma unroll
        for (int ks = 0; ks < 4; ++ks) { const s16x4 lo = vtr(vp + d0 * 4096 + ks * 1024), hh = vtr(vp + d0 * 4096 + ks * 1024 + 512);
            const bf16x8 vf = (bf16x8){lo[0], lo[1], lo[2], lo[3], hh[0], hh[1], hh[2], hh[3]};
            o[d0] = mfma32(__builtin_bit_cast(bf16x8, pw[ks]), vf, o[d0]); }
}
__device__ __forceinline__ void row_bcast(float (&f)[16], float x, LAS float* wsf, int r32, int hi) {
    if (hi == 0) wsf[r32] = x;
#pragma unroll
    for (int g = 0; g < 4; ++g) { const f32x4 t = *(const LAS f32x4*)(wsf + 8 * g + 4 * hi); f[4 * g] = t[0]; f[4 * g + 1] = t[1]; f[4 * g + 2] = t[2]; f[4 * g + 3] = t[3]; }
}
__device__ __forceinline__ void tile_update(f32x16& p0, f32x16& p1, float& m, float& l, f32x16 (&o)[2], LAS float* wsf, const LAS unsigned char* vslot, int lane, int r32, int hi) {
    float rm = fmaxf(p0[0], p1[0]);
#pragma unroll
    for (int r = 1; r < 16; ++r) rm = fmaxf(rm, fmaxf(p0[r], p1[r]));
    rm = fmaxf(rm, swap32(rm));
    const float mn = fmaxf(m, rm), f = fast_exp2(m - mn);
    m = mn;
    float s = 0.f;
#pragma unroll
    for (int r = 0; r < 16; ++r) { p0[r] = fast_exp2(p0[r] - mn); p1[r] = fast_exp2(p1[r] - mn); s += p0[r] + p1[r]; }
    l = l * f + s;
    if (__any(f != 1.0f)) { float fr[16]; row_bcast(fr, f, wsf, r32, hi);
#pragma unroll
        for (int r = 0; r < 16; ++r) { o[0][r] *= fr[r]; o[1][r] *= fr[r]; } }
    pv(o, vslot, p0, p1, lane, hi);
}

__device__ __forceinline__ void tile_update_rel(f32x16& p0, f32x16& p1, float& m, float& l, f32x16 (&o)[2], const LAS unsigned char* vslot, int lane, int hi, bool first) {
    if (first) {
        float rm = fmaxf(p0[0], p1[0]);
#pragma unroll
        for (int r = 1; r < 16; ++r) rm = fmaxf(rm, fmaxf(p0[r], p1[r]));
        rm = fmaxf(pairmax32(rm), 0.f);
        m += rm;
#pragma unroll
        for (int r = 0; r < 16; ++r) { p0[r] -= rm; p1[r] -= rm; }
    }
    float s = 0.f;
#pragma unroll
    for (int r = 0; r < 16; ++r) { p0[r] = fast_exp2(p0[r]); p1[r] = fast_exp2(p1[r]); s += p0[r] + p1[r]; }
    l += s;
    pv(o, vslot, p0, p1, lane, hi);
}

__device__ __forceinline__ void attn_unit(const Args& A, LAS unsigned char* lds, int b, int g, int qt, int tid, int wave, int lane) {
    const bf16* PROJ = (const bf16*)(A.ws + WS_PROJ); bf16* MIX = (bf16*)(A.ws + WS_MIX);
    const bf16* KC = (const bf16*)(A.ws + WS_KC) + (size_t)(b * 2 + g) * 128 * 64; const bf16* VC = (const bf16*)(A.ws + WS_VC) + (size_t)(b * 2 + g) * 128 * 64;
    const bf16* KS = (const bf16*)(A.ws + WS_KS) + (size_t)(b * 2 + g) * SEQ * 64; const bf16* VS = (const bf16*)(A.ws + WS_VS) + (size_t)(b * 2 + g) * SEQ * 64;
    const bf16* KW = (const bf16*)(A.ws + WS_KW) + (size_t)(b * 2 + g) * SEQ * 64; const bf16* VW = (const bf16*)(A.ws + WS_VW) + (size_t)(b * 2 + g) * SEQ * 64;
    const int r32 = lane & 31, hi = lane >> 5, rh = wave >> 1, th = wave & 1, hr = g * 4 + rh;
    const int tq = qt * 64 + th * 32 + r32;
    const size_t row = (size_t)b * SEQ + tq;
    LAS float* wsf = (LAS float*)(lds + A_WSF) + wave * 128;
    LAS float* IMP = (LAS float*)(lds + A_IMP); LAS float* IMPS = (LAS float*)(lds + A_IMPS);
    LAS unsigned* SELM = (LAS unsigned*)(lds + A_SELM); LAS unsigned* ANYM = (LAS unsigned*)(lds + A_ANY);
    const float slope2 = exp2f(-(float)(hr + 1)) * LOG2E;
    bf16x8 qr[4];
    { float qv[32]; float ss = 0.f;
#pragma unroll
        for (int d0 = 0; d0 < 4; ++d0) { const v4u raw = *(const v4u*)(PROJ + row * NPROJ + hr * 64 + d0 * 16 + hi * 8);
            qv[8 * d0 + 0] = bflo(raw.x); qv[8 * d0 + 1] = bfhi(raw.x); qv[8 * d0 + 2] = bflo(raw.y); qv[8 * d0 + 3] = bfhi(raw.y);
            qv[8 * d0 + 4] = bflo(raw.z); qv[8 * d0 + 5] = bfhi(raw.z); qv[8 * d0 + 6] = bflo(raw.w); qv[8 * d0 + 7] = bfhi(raw.w); }
#pragma unroll
        for (int i = 0; i < 32; ++i) ss += qv[i] * qv[i];
        ss += swap32(ss);
        const float sc = rsqrtf(ss * (1.0f / 64.0f) + EPS) * (0.125f * LOG2E);
#pragma unroll
        for (int d0 = 0; d0 < 4; ++d0) { v4u w;
#pragma unroll
            for (int i = 0; i < 4; ++i) { const int d = d0 * 16 + hi * 8 + 2 * i; w[i] = cvtpk(qv[8 * d0 + 2 * i] * sc * A.qkg[d], qv[8 * d0 + 2 * i + 1] * sc * A.qkg[d + 1]); }
            qr[d0] = __builtin_bit_cast(bf16x8, w); } }
    const float g_c = sigmoidf_(bf2f(PROJ[row * NPROJ + C_GATE + hr * 3 + 0])), g_s = sigmoidf_(bf2f(PROJ[row * NPROJ + C_GATE + hr * 3 + 1])), g_w = sigmoidf_(bf2f(PROJ[row * NPROJ + C_GATE + hr * 3 + 2]));
    f32x16 oacc[2], o[2], p0, p1;
    if (tid < 64) SELM[tid] = 0u;
    if (tid == 64) ANYM[0] = 0u;
    const bool two = qt >= 16;
    stage_kv(lds, A_K0, A_V0, KC, VC, wave, lane);
    if (two) stage_kv(lds, A_K1, A_V1, KC + 64 * 64, VC + 64 * 64, wave, lane);
    __syncthreads();
    {
        f32x16 p2, p3;
        qkt(p0, p1, lds + A_K0, qr, r32, hi);
        if (two) qkt(p2, p3, lds + A_K1, qr, r32, hi);
        else {
#pragma unroll
            for (int r = 0; r < 16; ++r) { p2[r] = NEG_MASK; p3[r] = NEG_MASK; } }
        const float bd = (float)(tq - 31 - 64 * hi);
        float rm = NEG_MASK;
#pragma unroll
        for (int r = 0; r < 16; ++r) { const float c16 = (float)(16 * ((r & 3) + 8 * (r >> 2)));
            const float d0_ = bd - c16, d1_ = d0_ - 512.f, d2_ = d0_ - 1024.f, d3_ = d0_ - 1536.f;
            p0[r] = d0_ >= 0.f ? p0[r] - slope2 * d0_ : NEG_MASK; p1[r] = d1_ >= 0.f ? p1[r] - slope2 * d1_ : NEG_MASK;
            p2[r] = (two && d2_ >= 0.f) ? p2[r] - slope2 * d2_ : NEG_MASK; p3[r] = (two && d3_ >= 0.f) ? p3[r] - slope2 * d3_ : NEG_MASK;
            rm = fmaxf(fmaxf(rm, fmaxf(p0[r], p1[r])), fmaxf(p2[r], p3[r])); }
        rm = fmaxf(rm, swap32(rm));
        const bool has = rm > -1e29f; const float mref = has ? rm : 0.f;
        float s = 0.f;
#pragma unroll
        for (int r = 0; r < 16; ++r) { p0[r] = fast_exp2(p0[r] - mref); p1[r] = fast_exp2(p1[r] - mref); p2[r] = fast_exp2(p2[r] - mref); p3[r] = fast_exp2(p3[r] - mref); s += (p0[r] + p1[r]) + (p2[r] + p3[r]); }
        s += swap32(s);
        const float inv = has ? 1.0f / s : 0.f;
#pragma unroll
        for (int r = 0; r < 16; ++r) { p0[r] *= inv; p1[r] *= inv; p2[r] *= inv; p3[r] *= inv; }
        float av[16], bv[16];
#pragma unroll
        for (int gq = 0; gq < 4; ++gq) {
            av[gq] = p0[4 * gq] + p0[4 * gq + 1] + p0[4 * gq + 2] + 0.5f * p0[4 * gq + 3]; bv[gq] = 0.5f * p0[4 * gq + 3];
            av[4 + gq] = p1[4 * gq] + p1[4 * gq + 1] + p1[4 * gq + 2] + 0.5f * p1[4 * gq + 3]; bv[4 + gq] = 0.5f * p1[4 * gq + 3];
            av[8 + gq] = p2[4 * gq] + p2[4 * gq + 1] + p2[4 * gq + 2] + 0.5f * p2[4 * gq + 3]; bv[8 + gq] = 0.5f * p2[4 * gq + 3];
            av[12 + gq] = p3[4 * gq] + p3[4 * gq + 1] + p3[4 * gq + 2] + 0.5f * p3[4 * gq + 3]; bv[12 + gq] = 0.5f * p3[4 * gq + 3]; }
        float prev = 0.f;
#pragma unroll
        for (int q = 0; q < 16; ++q) { const float rc = swap32(bv[q]); const float v = av[q] + (hi ? rc : prev); prev = rc;
            IMP[(rh * 64 + th * 32 + r32) * 33 + 2 * q + hi] = v; }
#pragma unroll
        for (int r = 0; r < 16; ++r) { o[0][r] = 0.f; o[1][r] = 0.f; }
        pv(o, lds + A_V0, p0, p1, lane, hi);
        if (two) pv(o, lds + A_V1, p2, p3, lane, hi);
        float fr[16]; row_bcast(fr, g_c, wsf, r32, hi);
#pragma unroll
        for (int r = 0; r < 16; ++r) { oacc[0][r] = o[0][r] * fr[r]; oacc[1][r] = o[1][r] * fr[r]; }
    }
    __syncthreads();
    { const int tok = tid >> 3, jq = tid & 7;
#pragma unroll
        for (int i = 0; i < 4; ++i) { const int j = 4 * jq + i; IMPS[tok * 33 + j] = (IMP[(0 * 64 + tok) * 33 + j] + IMP[(1 * 64 + tok) * 33 + j]) + (IMP[(2 * 64 + tok) * 33 + j] + IMP[(3 * 64 + tok) * 33 + j]); } }
    __syncthreads();
    { const int tok = tid >> 3, jq = tid & 7; unsigned bits = 0u;
        if (qt >= 16) { unsigned kk[32];
#pragma unroll
            for (int j = 0; j < 32; ++j) { const unsigned fb = __float_as_uint(IMPS[tok * 33 + j]); kk[j] = (j >= 1 && j <= qt - 2) ? ((fb & ~31u) | (unsigned)(31 - j)) : 0u; }
#pragma unroll
            for (int i = 0; i < 4; ++i) { const int j = 4 * jq + i; const unsigned kj = (__float_as_uint(IMPS[tok * 33 + j]) & ~31u) | (unsigned)(31 - j);
                int cnt = 0;
#pragma unroll
                for (int jj = 1; jj < 31; ++jj) cnt += (kk[jj] > kj) ? 1 : 0;
                const bool forced = (j == 0) || (j == qt) || (j == qt - 1);
                const bool sel = forced || (j >= 1 && j <= qt - 2 && cnt < 13);
                bits |= sel ? (1u << j) : 0u; } }
        else {
#pragma unroll
            for (int i = 0; i < 4; ++i) { const int j = 4 * jq + i; bits |= (j <= qt) ? (1u << j) : 0u; } }
        atomicOr((unsigned*)&SELM[tok], bits); atomicOr((unsigned*)&ANYM[0], bits); }
    __syncthreads();
    const unsigned mysel = SELM[th * 32 + r32], anym = ANYM[0];
    float m = 0.f, l = 0.f;
#pragma unroll
    for (int r = 0; r < 16; ++r) { o[0][r] = 0.f; o[1][r] = 0.f; }
    const int jlo = qt >= 8 ? qt - 8 : 0, nwt = qt - jlo + 1;
    unsigned rem = (unsigned)__builtin_amdgcn_readfirstlane((int)(anym & (qt == 31 ? 0xFFFFFFFFu : ((2u << qt) - 1u))));
    int wi = 0;
#define ATT_NEXT(kind_, j_, ok_) do { if (rem) { kind_ = 0; j_ = 31 - __builtin_clz(rem); rem &= ~(1u << j_); ok_ = true; } \
        else if (wi < nwt) { kind_ = 1; j_ = qt - wi; ++wi; ok_ = true; } else { ok_ = false; } } while (0)
#define ATT_LOAD(kind_, j_, kx_, vx_) do { const bf16* Kp_ = ((kind_) ? KW : KS) + (size_t)(j_) * 4096; const bf16* Vp_ = ((kind_) ? VW : VS) + (size_t)(j_) * 4096; \
        kx_ = *(const v4u*)(Kp_ + lane * 64 + wave * 8); vx_ = *(const v4u*)(Vp_ + (16 * (wave & 3) + (lane >> 2)) * 64 + (wave >> 2) * 32 + (lane & 3) * 8); } while (0)
#define ATT_STORE(slot_, kx_, vx_) do { *(LAS v4u*)(lds + ((slot_) ? A_K1 : A_K0) + wave * 1024 + lane * 16) = kx_; *(LAS v4u*)(lds + ((slot_) ? A_V1 : A_V0) + wave * 1024 + lane * 16) = vx_; } while (0)
    int ck, cj, nk = 0, nj = 0; bool cok, nok; v4u kx, vx;
    ATT_NEXT(ck, cj, cok);
    ATT_LOAD(ck, cj, kx, vx); ATT_STORE(0, kx, vx);
    ATT_NEXT(nk, nj, nok);
    __syncthreads();
    int slot = 0, pk = 0; bool first = true;
    while (cok) {
        if (nok) ATT_LOAD(nk, nj, kx, vx);
        if (ck != pk) {
            l = pairsum32(l); float fr[16]; row_bcast(fr, g_s / l, wsf, r32, hi);
#pragma unroll
            for (int r = 0; r < 16; ++r) { oacc[0][r] += o[0][r] * fr[r]; oacc[1][r] += o[1][r] * fr[r]; o[0][r] = 0.f; o[1][r] = 0.f; }
            m = 0.f; l = 0.f; pk = ck; first = true; }
        const bool isw = ck != 0; const bool ok = isw || ((mysel >> cj) & 1u); const float bd = (float)(tq - 64 * cj - 4 * hi);
        if (cj != qt && !(isw && cj == qt - 8)) {
            const float beff = ok ? -slope2 * bd - m : NEG_MASK;
#pragma unroll
            for (int r = 0; r < 16; ++r) { p0[r] = fmaf(slope2, (float)((r & 3) + 8 * (r >> 2)), beff); p1[r] = fmaf(slope2, (float)((r & 3) + 8 * (r >> 2) + 32), beff); }
            qkt_acc(p0, p1, lds + (slot ? A_K1 : A_K0), qr, r32, hi);
        } else {
            qkt(p0, p1, lds + (slot ? A_K1 : A_K0), qr, r32, hi);
            const float lim = isw ? 512.f : 1e9f;
#pragma unroll
            for (int r = 0; r < 16; ++r) { const float d0_ = bd - (float)((r & 3) + 8 * (r >> 2)), d1_ = d0_ - 32.f;
                p0[r] = (ok && d0_ >= 0.f && d0_ < lim) ? p0[r] - slope2 * d0_ - m : NEG_MASK; p1[r] = (ok && d1_ >= 0.f && d1_ < lim) ? p1[r] - slope2 * d1_ - m : NEG_MASK; } }
        tile_update_rel(p0, p1, m, l, o, lds + (slot ? A_V1 : A_V0), lane, hi, first); first = false;
        if (nok) ATT_STORE(slot ^ 1, kx, vx);
        __syncthreads();
        slot ^= 1; ck = nk; cj = nj; cok = nok;
        if (cok) ATT_NEXT(nk, nj, nok);
    }
    { l = pairsum32(l); float fr[16]; row_bcast(fr, g_w / l, wsf, r32, hi);
#pragma unroll
        for (int r = 0; r < 16; ++r) { oacc[0][r] += o[0][r] * fr[r]; oacc[1][r] += o[1][r] * fr[r]; } }
#undef ATT_NEXT
#undef ATT_LOAD
#undef ATT_STORE
    { bf16* ob = MIX + ((size_t)b * SEQ + qt * 64 + th * 32) * DM + hr * 64 + r32;
#pragma unroll
        for (int r = 0; r < 16; ++r) { const int q = crow(r, hi);
            ob[(size_t)q * DM] = (bf16)(cvtpk(oacc[0][r], 0.f) & 0xffffu); ob[(size_t)q * DM + 32] = (bf16)(cvtpk(oacc[1][r], 0.f) & 0xffffu); } }
    __syncthreads();
}

__device__ __forceinline__ void ins16(float (&L)[16], float x) {
#pragma unroll
    for (int i = 15; i >= 1; --i) L[i] = __builtin_amdgcn_fmed3f(x, L[i - 1], L[i]);
    L[0] = fmaxf(L[0], x);
}
__device__ __forceinline__ float sel16(const float (&L)[16], int a) { float r = L[0];
#pragma unroll
    for (int i = 1; i < 16; ++i) r = (a == i) ? L[i] : r;
    return r; }
#define CE(hi_, lo_) do { float t_, u_; asm("v_max_f32 %0, %1, %2" : "=v"(t_) : "v"(hi_), "v"(lo_)); asm("v_min_f32 %0, %1, %2" : "=v"(u_) : "v"(hi_), "v"(lo_)); hi_ = t_; lo_ = u_; } while (0)
#define SORT16_DESC(A) do { CE(A[0], A[1]); CE(A[3], A[2]); CE(A[4], A[5]); CE(A[7], A[6]); CE(A[8], A[9]); CE(A[11], A[10]); CE(A[12], A[13]); CE(A[15], A[14]); CE(A[0], A[2]); CE(A[1], A[3]); CE(A[6], A[4]); CE(A[7], A[5]); CE(A[8], A[10]); CE(A[9], A[11]); CE(A[14], A[12]); CE(A[15], A[13]); CE(A[0], A[1]); CE(A[2], A[3]); CE(A[5], A[4]); CE(A[7], A[6]); CE(A[8], A[9]); CE(A[10], A[11]); CE(A[13], A[12]); CE(A[15], A[14]); CE(A[0], A[4]); CE(A[1], A[5]); CE(A[2], A[6]); CE(A[3], A[7]); CE(A[12], A[8]); CE(A[13], A[9]); CE(A[14], A[10]); CE(A[15], A[11]); CE(A[0], A[2]); CE(A[1], A[3]); CE(A[4], A[6]); CE(A[5], A[7]); CE(A[10], A[8]); CE(A[11], A[9]); CE(A[14], A[12]); CE(A[15], A[13]); CE(A[0], A[1]); CE(A[2], A[3]); CE(A[4], A[5]); CE(A[6], A[7]); CE(A[9], A[8]); CE(A[11], A[10]); CE(A[13], A[12]); CE(A[15], A[14]); CE(A[0], A[8]); CE(A[1], A[9]); CE(A[2], A[10]); CE(A[3], A[11]); CE(A[4], A[12]); CE(A[5], A[13]); CE(A[6], A[14]); CE(A[7], A[15]); CE(A[0], A[4]); CE(A[1], A[5]); CE(A[2], A[6]); CE(A[3], A[7]); CE(A[8], A[12]); CE(A[9], A[13]); CE(A[10], A[14]); CE(A[11], A[15]); CE(A[0], A[2]); CE(A[1], A[3]); CE(A[4], A[6]); CE(A[5], A[7]); CE(A[8], A[10]); CE(A[9], A[11]); CE(A[12], A[14]); CE(A[13], A[15]); CE(A[0], A[1]); CE(A[2], A[3]); CE(A[4], A[5]); CE(A[6], A[7]); CE(A[8], A[9]); CE(A[10], A[11]); CE(A[12], A[13]); CE(A[14], A[15]); } while (0)
#define MERGE16_DESC(A) do { CE(A[0], A[8]); CE(A[1], A[9]); CE(A[2], A[10]); CE(A[3], A[11]); CE(A[4], A[12]); CE(A[5], A[13]); CE(A[6], A[14]); CE(A[7], A[15]); CE(A[0], A[4]); CE(A[1], A[5]); CE(A[2], A[6]); CE(A[3], A[7]); CE(A[8], A[12]); CE(A[9], A[13]); CE(A[10], A[14]); CE(A[11], A[15]); CE(A[0], A[2]); CE(A[1], A[3]); CE(A[4], A[6]); CE(A[5], A[7]); CE(A[8], A[10]); CE(A[9], A[11]); CE(A[12], A[14]); CE(A[13], A[15]); CE(A[0], A[1]); CE(A[2], A[3]); CE(A[4], A[5]); CE(A[6], A[7]); CE(A[8], A[9]); CE(A[10], A[11]); CE(A[12], A[13]); CE(A[14], A[15]); } while (0)
__device__ __forceinline__ float vmaxf_(float a, float b) { float r; asm("v_max_f32 %0, %1, %2" : "=v"(r) : "v"(a), "v"(b)); return r; }
constexpr int SK_ROW = 136;
__device__ __forceinline__ void peer_half(const bf16* QP, const LAS bf16* SK, int t0, int h, int c, int r32, int hi, float (&Lc)[16]) {
    f32x16 acc[4];
#pragma unroll
    for (int kt = 0; kt < 4; ++kt)
#pragma unroll
        for (int r = 0; r < 16; ++r) acc[kt][r] = 0.f;
    bf16x8 bq[8];
#pragma unroll
    for (int ks = 0; ks < 8; ++ks) bq[ks] = *(const bf16x8*)(QP + (size_t)(t0 + r32) * NQP + h * 256 + c * 128 + ks * 16 + hi * 8);
#pragma unroll
    for (int ks = 0; ks < 8; ++ks) {
#pragma unroll
        for (int kt = 0; kt < 4; ++kt) { const bf16x8 ak = *(const LAS bf16x8*)(SK + (c * 128 + kt * 32 + r32) * SK_ROW + ks * 16 + hi * 8); acc[kt] = mfma32(ak, bq[ks], acc[kt]); } }
    float g0[16], g1[16], g2[16], g3[16];
#pragma unroll
    for (int r = 0; r < 16; ++r) { const unsigned kb = (unsigned)((r & 3) + 8 * (r >> 2) + 4 * hi);
        g0[r] = __uint_as_float((__float_as_uint(acc[0][r]) & ~0x7Fu) | (127u - kb)); g1[r] = __uint_as_float((__float_as_uint(acc[1][r]) & ~0x7Fu) | (95u - kb));
        g2[r] = __uint_as_float((__float_as_uint(acc[2][r]) & ~0x7Fu) | (63u - kb)); g3[r] = __uint_as_float((__float_as_uint(acc[3][r]) & ~0x7Fu) | (31u - kb)); }
    SORT16_DESC(g0); SORT16_DESC(g1); SORT16_DESC(g2); SORT16_DESC(g3);
#pragma unroll
    for (int i = 0; i < 16; ++i) { g0[i] = vmaxf_(g0[i], g1[15 - i]); g2[i] = vmaxf_(g2[i], g3[15 - i]); }
    MERGE16_DESC(g0); MERGE16_DESC(g2);
#pragma unroll
    for (int i = 0; i < 16; ++i) Lc[i] = vmaxf_(g0[i], g2[15 - i]);
    MERGE16_DESC(Lc);
    float P[16];
#pragma unroll
    for (int i = 0; i < 16; ++i) P[i] = swap32(Lc[15 - i]);
#pragma unroll
    for (int i = 0; i < 16; ++i) Lc[i] = vmaxf_(Lc[i], P[i]);
    MERGE16_DESC(Lc);
}
__device__ __forceinline__ void peer_stage_subkeys(const Args& A, LAS unsigned char* lds, int h, int tid) {
    const bf16* SUBK = (const bf16*)(A.ws + WS_SUBK) + (size_t)h * 2 * 128 * 128; LAS bf16* SK = (LAS bf16*)lds;
    for (int c = tid; c < 256 * 16; c += NTHR) { const int row = c >> 4, ch = c & 15; *(LAS v4u*)(SK + row * SK_ROW + ch * 8) = *(const v4u*)(SUBK + row * 128 + ch * 8); }
    __syncthreads();
}
__device__ __forceinline__ void peer_topk_unit(const Args& A, LAS unsigned char* lds, int h, int tb, int wave, int lane) {
    const bf16* QP = (const bf16*)(A.ws + WS_QP); const LAS bf16* SK = (const LAS bf16*)lds;
    const int r32 = lane & 31, hi = lane >> 5, t0 = tb * 256 + wave * 32;
    float L0[16], L1[16];
    peer_half(QP, SK, t0, h, 0, r32, hi, L0);
    peer_half(QP, SK, t0, h, 1, r32, hi, L1);
    LAS int* IDXT = (LAS int*)(lds + 69632) + wave * (32 * 33) + r32 * 33;
#pragma unroll
    for (int i = 0; i < 16; ++i) { IDXT[i] = 127 - (int)(__float_as_uint(L0[i]) & 0x7Fu); IDXT[16 + i] = 127 - (int)(__float_as_uint(L1[i]) & 0x7Fu); }
    float F[16];
#pragma unroll
    for (int bb = 0; bb < 16; ++bb) { const float v = __uint_as_float(__float_as_uint(L0[0]) & ~0x7Fu) + __uint_as_float(__float_as_uint(L1[bb]) & ~0x7Fu);
        F[bb] = __uint_as_float((__float_as_uint(v) & ~0xFFu) | (255u - (unsigned)bb)); }
#pragma unroll
    for (int a = 1; a < 16; ++a)
#pragma unroll
        for (int bb = 0; bb < 16; ++bb) if ((a + 1) * (bb + 1) <= 16) {
            const float v = __uint_as_float(__float_as_uint(L0[a]) & ~0x7Fu) + __uint_as_float(__float_as_uint(L1[bb]) & ~0x7Fu);
            ins16(F, __uint_as_float((__float_as_uint(v) & ~0xFFu) | (255u - (unsigned)(a * 16 + bb)))); }
    float sv[16]; int ev[16]; float sum = 0.f;
    const float mx = __uint_as_float(__float_as_uint(F[0]) & ~0xFFu);
#pragma unroll
    for (int k = 0; k < 16; ++k) { const unsigned code = 255u - (__float_as_uint(F[k]) & 0xFFu); const int a = (int)(code >> 4), bb = (int)(code & 15u);
        const float s = __uint_as_float(__float_as_uint(F[k]) & ~0xFFu);
        const int i1 = IDXT[a], i2 = IDXT[16 + bb];
        ev[k] = i1 * 128 + i2; sv[k] = __expf(s - mx); sum += sv[k]; }
    const float inv = 1.0f / sum;
    { const float* SU = (const float*)(A.ws + WS_SU); const float* SV = (const float*)(A.ws + WS_SV);
      v2u* EG = (v2u*)(A.ws + WS_ENTG) + (size_t)(t0 + r32) * 128 + h * 16 + hi * 8;
#pragma unroll
      for (int k = 0; k < 16; ++k) { if ((k >> 3) == hi) { const int e = ev[k]; const unsigned gwb = cvtpk(sv[k] * inv, 0.f) & 0x7FFFu;
            EG[k & 7] = (v2u){(unsigned)e | (gwb << 17), cvtpk(SU[e], SV[e])}; } } }
}
__device__ __forceinline__ void peer_order_wave(const Args& A, LAS unsigned char* lds, int wg, int wave, int lane) {
    LAS unsigned* Hc = (LAS unsigned*)lds + wave * 256; LAS unsigned* S1 = Hc + 128;
    Hc[lane] = 0u; Hc[64 + lane] = 0u;
    const v2u* EG = (const v2u*)(A.ws + WS_ENTG) + (size_t)wg * 1024;
    unsigned w0r[16], w1r[16], rr[16];
#pragma unroll
    for (int j = 0; j < 16; ++j) { const v2u w = EG[j * 64 + lane]; w0r[j] = w.x | ((unsigned)(j >> 1) << 14); w1r[j] = w.y; }
#pragma unroll
    for (int j = 0; j < 16; ++j) { const unsigned sl = (w0r[j] & 0x3FFFu) >> 8; rr[j] = atomicAdd((unsigned*)&Hc[sl * 2 + (j >> 3)], 1u); }
    const unsigned c0 = Hc[2 * lane], c1 = Hc[2 * lane + 1], p0 = c0, p1 = c1, tot = p0 + p1;
    unsigned incl = tot;
#pragma unroll
    for (int o = 1; o < 64; o <<= 1) { const unsigned up = __shfl_up(incl, o); incl += (lane >= o) ? up : 0u; }
    const unsigned base0 = incl - tot, base1 = base0 + p0;
    S1[2 * lane] = base0; S1[2 * lane + 1] = base1;
    unsigned char* MB = A.ws + WS_META + (size_t)wg * META_STRIDE;
    v2u* MG = (v2u*)(MB + 128);
#pragma unroll
    for (int j = 0; j < 16; ++j) { const unsigned sl = (w0r[j] & 0x3FFFu) >> 8; const unsigned pos = S1[sl * 2 + (j >> 3)] + rr[j];
        MG[pos] = (v2u){w0r[j], w1r[j]}; }
}

__device__ __forceinline__ void glds16s(const void* sbase, unsigned voff, unsigned ldsaddr) {
    asm volatile("s_mov_b32 m0, %2\n\ts_nop 0\n\tglobal_load_lds_dwordx4 %0, %1" : : "v"(voff), "s"(sbase), "s"(ldsaddr) : "memory", "m0");
}
__device__ __forceinline__ float gelu_erf(float v) {
    const float av = fabsf(v), t = __builtin_amdgcn_rcpf(av * 0.2316418882f + 1.0f);
    float q = t * 0.5307027145f + (-0.7265760135f); q = q * t + 0.7107068705f; q = q * t + (-0.142248368f); q = q * t + 0.127414796f; q = q * t;
    const float e = __builtin_amdgcn_exp2f((v * v) * (-0.72134752044f)), m = v * (q * e);
    return v < 0.f ? m : v - m;
}
__device__ __forceinline__ void peer_gather_wave(const Args& A, LAS unsigned char* lds, int wg, int wave, int lane, bool final_pass) {
    const unsigned char* U8 = A.ws + WS_U8; const unsigned char* V8 = A.ws + WS_V8; const unsigned char* H8 = A.ws + WS_H8;
    const float* SH = (const float*)(A.ws + WS_SH); const float* MODF = (const float*)(A.ws + WS_MOD);
    LAS unsigned char* GBUF = lds + wave * PG_WSTRIDE;
    const unsigned gbuf_addr = (unsigned)__builtin_amdgcn_readfirstlane((int)(unsigned)(uintptr_t)GBUF);
    const unsigned metaw_addr = gbuf_addr + 16384;
    LAS unsigned* METAW = (LAS unsigned*)(lds + wave * PG_WSTRIDE + 16384);
    LAS unsigned short* AT = (LAS unsigned short*)(lds + wave * PG_WSTRIDE + 17408);
    LAS float* SHT = (LAS float*)(lds + LDS_CTL_OFF + 256 + wave * 32);
    const unsigned char* MB = A.ws + WS_META + (size_t)wg * META_STRIDE;
    const unsigned char* MGL = MB + 128 + 16 * (lane & 31);
    if (lane < 8) SHT[lane] = SH[8 * wg + lane];
    constexpr int ngtot = 256;
#define PG_META_CHUNK(c_) do { if (lane < 32) glds16s(MB, (unsigned)(128 + 16 * (lane & 31) + (c_) * 512), metaw_addr + ((c_) & 1) * 512); } while (0)
    PG_META_CHUNK(0); PG_META_CHUNK(1);
    asm volatile("s_waitcnt vmcnt(0) lgkmcnt(0)" ::: "memory");
    {
        const int ntot = 4 * ngtot, ng16 = (ntot + 15) >> 4;
        const int jl = lane & 15, kq = lane >> 4;
        v4i HA[16];
#pragma unroll
        for (int ks = 0; ks < 16; ++ks) HA[ks] = jl < 8 ? *(const v4i*)(H8 + (size_t)(8 * wg + jl) * DM + 64 * ks + 16 * kq) : (v4i){0, 0, 0, 0};
#define PGA_BASES(g_, B_) do { _Pragma("unroll") for (int d_ = 0; d_ < 4; ++d_) { int idx_ = 16 * (g_) + 4 * d_ + kq; idx_ = idx_ < ntot ? idx_ : ntot - 1; \
            const unsigned e_ = METAW[(idx_ & 127) * 2] & 0x3FFFu; B_[d_] = e_ * DM + ((jl ^ (4 * d_ + kq)) << 4); } } while (0)
#define PGA_ISSUE(B_, q_) do { _Pragma("unroll") for (int d_ = 0; d_ < 4; ++d_) glds16s(U8, B_[d_] + (q_) * 256, gbuf_addr + (q_) * 4096 + d_ * 1024); } while (0)
#define PGA_MMA(q_) do { const LAS unsigned char* gb_ = GBUF + (q_) * 4096 + jl * 256; _Pragma("unroll") for (int k4_ = 0; k4_ < 4; ++k4_) { \
            const v4i bf_ = *(const LAS v4i*)(gb_ + (((4 * k4_ + kq) ^ jl) << 4)); zacc = __builtin_amdgcn_mfma_i32_16x16x64_i8(HA[4 * (q_) + k4_], bf_, zacc, 0, 0, 0); } asm volatile("s_waitcnt lgkmcnt(0)" ::: "memory"); } while (0)
        unsigned bc[4], bn[4];
        PGA_BASES(0, bc);
        PGA_ISSUE(bc, 0); PGA_ISSUE(bc, 1); PGA_ISSUE(bc, 2);
        for (int g = 0; g < ng16; ++g) {
            if ((g & 3) == 0 && g > 0 && (g >> 2) + 1 <= 21) PG_META_CHUNK((g >> 2) + 1);
            const int gn = g + 1 < ng16 ? g + 1 : ng16 - 1;
            PGA_BASES(gn, bn);
            v4i zacc = (v4i){0, 0, 0, 0};
            PGA_ISSUE(bc, 3);
            asm volatile("s_waitcnt vmcnt(12)" ::: "memory"); PGA_MMA(0);
            PGA_ISSUE(bn, 0);
            asm volatile("s_waitcnt vmcnt(12)" ::: "memory"); PGA_MMA(1);
            PGA_ISSUE(bn, 1);
            asm volatile("s_waitcnt vmcnt(12)" ::: "memory"); PGA_MMA(2);
            PGA_ISSUE(bn, 2);
            asm volatile("s_waitcnt vmcnt(12)" ::: "memory"); PGA_MMA(3);
            { const int idx = 16 * g + jl; const unsigned w0 = METAW[(idx & 127) * 2], w1 = METAW[(idx & 127) * 2 + 1]; const unsigned tj = (w0 >> 14) & 7u;
              if (idx < ntot && (int)(tj >> 2) == kq) { const unsigned ts = tj & 3u; const int zi = ts == 0 ? zacc[0] : ts == 1 ? zacc[1] : ts == 2 ? zacc[2] : zacc[3];
                  const float z = (float)zi * bflo(w1) * SHT[tj];
                  AT[idx] = (unsigned short)((cvtpk(__uint_as_float((w0 >> 17) << 16) * gelu_erf(z) * bfhi(w1), 0.f) & 0xFFF8u) | tj); } }
#pragma unroll
            for (int d = 0; d < 4; ++d) bc[d] = bn[d];
        }
#undef PGA_BASES
#undef PGA_ISSUE
#undef PGA_MMA
    }
    asm volatile("s_waitcnt vmcnt(0) lgkmcnt(0)" ::: "memory");
    const int ntot = 4 * ngtot, nblk = (ntot + 31) >> 5;
    LAS unsigned char* A8 = (LAS unsigned char*)AT; LAS unsigned char* TK = A8 + 1408;
    float sa;
    {
        unsigned raw[22]; float cm = 0.f;
#pragma unroll
        for (int i = 0; i < 22; ++i) { const int n = lane + 64 * i; raw[i] = n < ntot ? (unsigned)AT[n] : 0u; cm = fmaxf(cm, fabsf(__uint_as_float((raw[i] & 0xFFF8u) << 16))); }
#pragma unroll
        for (int o = 1; o < 64; o <<= 1) cm = fmaxf(cm, __shfl_xor(cm, o));
        sa = cm > 0.f ? cm * (1.0f / 256.0f) : 1.0f; const float isa = 1.0f / sa;
        asm volatile("s_waitcnt lgkmcnt(0)" ::: "memory");
#pragma unroll
        for (int i = 0; i < 22; ++i) { const int n = lane + 64 * i; const float c = __uint_as_float((raw[i] & 0xFFF8u) << 16) * isa;
            A8[n] = (unsigned char)(__builtin_amdgcn_cvt_pk_fp8_f32(c, 0.f, 0, false) & 0xFF); TK[n] = (unsigned char)(raw[i] & 7u); }
        asm volatile("s_waitcnt lgkmcnt(0)" ::: "memory");
    }
    const int i16 = lane & 15, kq = lane >> 4;
    const int tb_ent = 8 * kq + (i16 >> 1);
    const int tb_off = tb_ent * 128 + 8 * (i16 & 1), tb_swz = (tb_ent >> 1) & 7;
    const float* gf = MODF + ((8 * wg) >> 11) * NMOD + 5 * DM;
    for (int ch = 0; ch < 2; ++ch) {
        f32x4 acc[32];
#pragma unroll
        for (int T = 0; T < 32; ++T) acc[T] = (f32x4){0.f, 0.f, 0.f, 0.f};
        PG_META_CHUNK(0); PG_META_CHUNK(1);
        asm volatile("s_waitcnt vmcnt(0) lgkmcnt(0)" ::: "memory");
#define PGB_BASE1(kb_, d_, sw_) ({ int idx_ = 32 * (kb_) + 8 * (d_) + (lane >> 3); idx_ = idx_ < ntot ? idx_ : ntot - 1; ((METAW[(idx_ & 127) * 2] & 0x3FFFu) << 10) + (unsigned)(ch * 512) + (sw_); })
#define PGB_SWZ(d_) ((unsigned)(((lane & 7) ^ ((8 * (d_) + (lane >> 3)) >> 1)) & 7) << 4)
#define PGB_BASES(kb_, B_) do { B_[0] = PGB_BASE1(kb_, 0, PGB_SWZ(0)); B_[1] = PGB_BASE1(kb_, 1, PGB_SWZ(1)); B_[2] = PGB_BASE1(kb_, 2, PGB_SWZ(2)); B_[3] = PGB_BASE1(kb_, 3, PGB_SWZ(3)); } while (0)
#define PGB_ISSUE(B_, q_) do { _Pragma("unroll") for (int d_ = 0; d_ < 4; ++d_) glds16s(V8, B_[d_] + (q_) * 128, gbuf_addr + (q_) * 4096 + d_ * 1024); } while (0)
#define PGB_MMA(q_) do { const LAS unsigned char* gb_ = GBUF + (q_) * 4096 + tb_off; _Pragma("unroll") for (int nt_ = 0; nt_ < 8; ++nt_) { \
            const v2i bf_ = __builtin_amdgcn_ds_read_tr8_b64_v2i32((LAS v2i*)(gb_ + ((nt_ ^ tb_swz) << 4))); \
            acc[8 * (q_) + nt_] = __builtin_amdgcn_mfma_f32_16x16x32_fp8_fp8(aop, __builtin_bit_cast(long, bf_), acc[8 * (q_) + nt_], 0, 0, 0); } \
            asm volatile("s_waitcnt lgkmcnt(0)" ::: "memory"); } while (0)
        unsigned bc[4], bn[4];
        PGB_BASES(0, bc);
        PGB_ISSUE(bc, 0); PGB_ISSUE(bc, 1); PGB_ISSUE(bc, 2);
        for (int kb = 0; kb < nblk; ++kb) {
            if ((kb & 1) == 0 && kb > 0 && (kb >> 1) + 1 <= 21) PG_META_CHUNK((kb >> 1) + 1);
            const int kn = kb + 1 < nblk ? kb + 1 : nblk - 1;
            PGB_BASES(kn, bn);
            long aop;
            { const v2u a8 = *(const LAS v2u*)(A8 + 32 * kb + 8 * kq), tk = *(const LAS v2u*)(TK + 32 * kb + 8 * kq); const unsigned mm = (unsigned)i16 * 0x01010101u;
              unsigned x0 = tk.x ^ mm, x1 = tk.y ^ mm;
              x0 = ((x0 & 0x7F7F7F7Fu) + 0x7F7F7F7Fu) | x0; x1 = ((x1 & 0x7F7F7F7Fu) + 0x7F7F7F7Fu) | x1;
              const unsigned k0 = ((~x0 & 0x80808080u) >> 7) * 0xFFu, k1 = ((~x1 & 0x80808080u) >> 7) * 0xFFu;
              aop = (long)(((unsigned long long)(a8.y & k1) << 32) | (unsigned long long)(a8.x & k0)); }
            PGB_ISSUE(bc, 3);
            asm volatile("s_waitcnt vmcnt(12)" ::: "memory"); PGB_MMA(0);
            PGB_ISSUE(bn, 0);
            asm volatile("s_waitcnt vmcnt(12)" ::: "memory"); PGB_MMA(1);
            PGB_ISSUE(bn, 1);
            asm volatile("s_waitcnt vmcnt(12)" ::: "memory"); PGB_MMA(2);
            PGB_ISSUE(bn, 2);
            asm volatile("s_waitcnt vmcnt(12)" ::: "memory"); PGB_MMA(3);
#pragma unroll
            for (int d = 0; d < 4; ++d) bc[d] = bn[d];
        }
#undef PGB_BASE1
#undef PGB_SWZ
#undef PGB_BASES
#undef PGB_ISSUE
#undef PGB_MMA
        asm volatile("s_waitcnt vmcnt(0) lgkmcnt(0)" ::: "memory");
        { LAS float* EP = (LAS float*)GBUF;
#pragma unroll
          for (int hq = 0; hq < 2; ++hq) {
            const int col = ch * 512 + hq * 256 + 4 * lane; const f32x4 g = *(const f32x4*)(gf + col) * sa;
            const float* xin = A.out + (size_t)(8 * wg) * DM + col; float* xout = final_pass ? A.out + (size_t)(8 * wg) * DM + col : (float*)(A.ws + WS_H) + (size_t)(8 * (wg & 511)) * DM + col;
            if (kq < 2) {
#pragma unroll
                for (int T = 0; T < 16; ++T)
#pragma unroll
                    for (int r = 0; r < 4; ++r) EP[(4 * kq + r) * 256 + T * 16 + i16] = acc[16 * hq + T][r]; }
            asm volatile("s_waitcnt lgkmcnt(0)" ::: "memory");
#pragma unroll 4
            for (int t = 0; t < 8; ++t) { const f32x4 v = *(const LAS f32x4*)(EP + t * 256 + 4 * lane);
                *(f32x4*)(xout + (size_t)t * DM) = *(const f32x4*)(xin + (size_t)t * DM) + g * v; }
            asm volatile("s_waitcnt lgkmcnt(0)" ::: "memory"); } }
    }
#undef PG_META_CHUNK
#undef PG_ISSUE_GROUP
#undef PG_META_GROUP
}

#define RLX_AGENT __ATOMIC_RELAXED, __HIP_MEMORY_SCOPE_AGENT
constexpr size_t WS_CTL = 240 * MiB, CTL_ZERO_BYTES = 65536;
constexpr int MISC_OFF = LDS_CTL_OFF + 64;
#define XB_TMO      128
#define XB_XCNT(j)  (256  + 64 * (j))
#define XB_XSUB(j)  (1280 + 64 * (j))
#define XB_XGEN(j)  (2304 + 64 * (j))
#define XB_TOP      3328
#define XB_TOPGEN   3392
#define XCD_BAR_WORDS 3456
#define XB_SPIN_CAP (1u << 18)

__device__ __forceinline__ unsigned xb_ld(unsigned* p)              { return __hip_atomic_load(p, __ATOMIC_RELAXED, __HIP_MEMORY_SCOPE_AGENT); }
__device__ __forceinline__ unsigned xb_add(unsigned* p, unsigned v) { return __hip_atomic_fetch_add(p, v, __ATOMIC_RELAXED, __HIP_MEMORY_SCOPE_AGENT); }
__device__ __forceinline__ unsigned xb_xcc_id() { return (unsigned)__builtin_amdgcn_s_getreg((3 << 11) | 20) & 0xFu; }
#define XB_SPIN(cond, bar) do { unsigned _sp = 0; while (cond) { __builtin_amdgcn_s_sleep(1); \
    if ((++_sp & 255u) == 0u) { if (xb_ld(&(bar)[XB_TMO])) break; if (_sp > XB_SPIN_CAP) { atomicAdd(&(bar)[XB_TMO], 1u); break; } } } } while (0)

struct XcdBarrier {
    unsigned* bar; unsigned x;
    volatile LAS unsigned* st;
};

__device__ __forceinline__ XcdBarrier xcd_barrier_post(unsigned* bar, volatile LAS unsigned* st) {
    XcdBarrier b; b.bar = bar; b.x = xb_xcc_id(); b.st = st;
    if (threadIdx.x == 0) (void)xb_add(&bar[XB_XCNT(b.x)], 1u);
    return b;
}
__device__ __forceinline__ void xcd_barrier_complete(unsigned* bar, unsigned x, unsigned& nloc, unsigned& nx) {
    const unsigned G = gridDim.x * gridDim.y * gridDim.z;
    unsigned sum, cnt, mine, sp = 0u;
    for (;;) {
        sum = 0u; cnt = 0u; mine = 0u;
#pragma unroll
        for (unsigned j = 0; j < 16; ++j) { const unsigned c = xb_ld(&bar[XB_XCNT(j)]); sum += c; cnt += (c > 0u) ? 1u : 0u; mine = (j == x) ? c : mine; }
        if (sum == G) break;
        __builtin_amdgcn_s_sleep(1);
        if ((++sp & 255u) == 0u) { if (xb_ld(&bar[XB_TMO])) break; if (sp > XB_SPIN_CAP) { atomicAdd(&bar[XB_TMO], 1u); break; } }
    }
    nloc = mine > 0u ? mine : 1u; nx = cnt > 0u ? cnt : 1u;
}

__device__ __forceinline__ void xcd_barrier(const XcdBarrier& b) {
    asm volatile("s_waitcnt vmcnt(0)" ::: "memory");
    __syncthreads();
    if (threadIdx.x == 0) {
        unsigned* bar = b.bar;
        __builtin_amdgcn_s_waitcnt(0);
        unsigned nloc = b.st[0], nx = b.st[1];
        if (nloc == 0u) { xcd_barrier_complete(bar, b.x, nloc, nx); b.st[0] = nloc; b.st[1] = nx; }
        const unsigned old = xb_add(&bar[XB_XSUB(b.x)], 1u);
        const unsigned gen = old / nloc;
        if (old + 1u == (gen + 1u) * nloc) {
            __builtin_amdgcn_fence(__ATOMIC_RELEASE, "agent");
            asm volatile("s_waitcnt vmcnt(0)" ::: "memory");
            const unsigned og = xb_add(&bar[XB_TOP], 1u);
            const unsigned tg = og / nx;
            if (og + 1u == (tg + 1u) * nx) xb_add(&bar[XB_TOPGEN], 1u);
            else XB_SPIN(xb_ld(&bar[XB_TOPGEN]) == tg, bar);
            __builtin_amdgcn_fence(__ATOMIC_ACQUIRE, "agent");
            xb_add(&bar[XB_XGEN(b.x)], 1u);
            asm volatile("s_waitcnt vmcnt(0)" ::: "memory");
        } else {
            XB_SPIN(xb_ld(&bar[XB_XGEN(b.x)]) == gen, bar);
            __builtin_amdgcn_fence(__ATOMIC_ACQUIRE, "agent");
            asm volatile("s_waitcnt vmcnt(0)" ::: "memory");
        }
    }
    __syncthreads();
}

__global__ void __launch_bounds__(NTHR, 2) fwd_megakernel(Args A) {
    extern __shared__ __attribute__((aligned(16))) unsigned char lds_raw[];
    LAS unsigned char* lds = (LAS unsigned char*)lds_raw;
    const int tid = threadIdx.x, lane = tid & 63, wave = __builtin_amdgcn_readfirstlane(tid >> 6);
    const int G = gridDim.x, blk = blockIdx.x;
    const int gw = blk * NWAVES + wave, NGW = G * NWAVES;
    unsigned char* ws = A.ws;
    for (int u = tid; u < (LDS_BYTES - LDS_CTL_OFF) / 4; u += NTHR) ((LAS unsigned*)(lds + LDS_CTL_OFF))[u] = 0u;
    __syncthreads();
    XcdBarrier bar = xcd_barrier_post((unsigned*)(ws + WS_CTL), (volatile LAS unsigned*)(lds + MISC_OFF) + 8);

#ifndef PHMASK
#define PHMASK 0x3ff
#endif
#define PH(k) ((PHMASK >> (k)) & 1)
#ifndef DUPMASK
#define DUPMASK 0
#endif
#define REP(k) for (int rep_ = 0; rep_ < 1 + ((DUPMASK >> (k)) & 1); ++rep_)
    REP(0) if (PH(0)) p0_prologue(A, lds, gw, NGW, tid, lane, wave, false);
    xcd_barrier(bar);
    if (PH(1)) mod_final(A, blk, tid);
    if (PH(1)) norm_mod<true, false>(A, A.x, A.norm_g, 0 * DM, 1 * DM, (bf16*)(ws + WS_H), blk, wave, lane);
    if (PH(0)) p0_prologue(A, lds, gw, NGW, tid, lane, wave, true);
    xcd_barrier(bar);
    if (PH(2)) { pg8::Gemm g{(const pg8::bf16_t*)(ws + WS_H), (const pg8::bf16_t*)(ws + WS_WIN), TOK, NPROJ, DM}; pg8::StaticOrder S; S.init(TOK, NPROJ, G, blk);
      pg8::EpiBf16<0> E{(pg8::bf16_t*)(ws + WS_PROJ), NPROJ, nullptr, 0, 0, 1.f};
      pg8::gemm_phase<pg8::EpiBf16<0>, pg8::StaticOrder, true, true>(lds, g, S, E);
    }
    xcd_barrier(bar);
    REP(10) for (int u = blk; u < 128; u += G) cmp_unit(A, lds, u, tid, wave, lane);
    REP(11) for (int u = blk; u < 512; u += G) conv_unit(A, lds, u, tid, wave, lane);
    REP(12) for (int u = blk; u < 256; u += G) knorm_item(A, u, wave, lane);
    xcd_barrier(bar);
    REP(4) if (PH(4)) for (int u = blk; u < 256; u += G) { const int bg = u >> 4, s = u & 15;
        attn_unit(A, lds, bg >> 1, bg & 1, 31 - s, tid, wave, lane);
        attn_unit(A, lds, bg >> 1, bg & 1, s, tid, wave, lane); }
    for (int u = blk; u < 256; u += G) { const int bg = u >> 4, s = u & 15;
        const int cnt = s == 0 ? 6 : s < 3 ? 4 : s < 6 ? 3 : s < 8 ? 2 : s < 13 ? 1 : 0;
        const int off = s == 0 ? 0 : s < 3 ? 6 + 4 * (s - 1) : s < 6 ? 14 + 3 * (s - 3) : s < 8 ? 23 + 2 * (s - 6) : 27 + (s - 8);
        for (int k = 0; k < cnt; ++k) tab_convert_item(A, (bg * 8 + wave) * 32 + off + k, lane); }
    xcd_barrier(bar);
    if (PH(5)) { pg8::Gemm g{(const pg8::bf16_t*)(ws + WS_MIX), (const pg8::bf16_t*)(ws + WS_WOUT), TOK, DM, DM}; pg8::StaticOrder S; S.init(TOK, DM, G, blk);
      pg8::EpiResGate E{A.x, A.out, DM, (const float*)(ws + WS_MOD) + 2 * DM, NMOD, SEQ};
      pg8::gemm_phase<pg8::EpiResGate, pg8::StaticOrder, true, true>(lds, g, S, E); }
    xcd_barrier(bar);
    if (PH(6)) norm_mod<false, true>(A, A.out, A.norm_g + DM, 3 * DM, 4 * DM, (bf16*)(ws + WS_H), blk, wave, lane);
    xcd_barrier(bar);
    if (PH(7)) { pg8::Gemm g{(const pg8::bf16_t*)(ws + WS_H), (const pg8::bf16_t*)(ws + WS_WQ), TOK, NQP, DM}; pg8::StaticOrder S; S.init(TOK, NQP, G, blk);
      pg8::EpiBf16<0> E{(pg8::bf16_t*)(ws + WS_QP), NQP, nullptr, 0, 0, 1.f};
      pg8::gemm_phase<pg8::EpiBf16<0>, pg8::StaticOrder, true, true>(lds, g, S, E); }
    xcd_barrier(bar);
    REP(8) if (PH(8)) { int hcur = -1;
        for (int u = blk; u < 8 * (TOK / 256); u += G) { const int h = u & 7, tb = u >> 3;
            if (h != hcur) { __syncthreads(); peer_stage_subkeys(A, lds, h, tid); hcur = h; }
            peer_topk_unit(A, lds, h, tb, wave, lane); } }
    xcd_barrier(bar);
    REP(13) for (int wgi = gw; wgi < TOK / 8; wgi += NGW) peer_order_wave(A, lds, wgi, wave, lane);
    xcd_barrier(bar);
    REP(9) if (PH(9)) for (int wgi = gw; wgi < TOK / 8; wgi += NGW) peer_gather_wave(A, lds, wgi, wave, lane, rep_ == ((DUPMASK >> 9) & 1));
}

extern "C" void kernel_launch(void* const* d_in, const int* in_sizes, int n_in, void* d_out, int out_size, void* d_ws, size_t ws_size, hipStream_t stream) {
    static int grid = 0;
    if (grid == 0) {
        if (n_in != 20 || out_size != TOK * DM || ws_size < WS_CTL + CTL_ZERO_BYTES) { fprintf(stderr, "kernel_launch: unexpected shapes (n_in %d, out %d, ws %zu)\n", n_in, out_size, ws_size); grid = -1; return; }
        int dev = 0, cus = 0, per_cu = 0;
        hipGetDevice(&dev); hipDeviceGetAttribute(&cus, hipDeviceAttributeMultiprocessorCount, dev);
        hipFuncSetAttribute((const void*)fwd_megakernel, hipFuncAttributeMaxDynamicSharedMemorySize, LDS_BYTES);
        hipOccupancyMaxActiveBlocksPerMultiprocessor(&per_cu, (const void*)fwd_megakernel, NTHR, LDS_BYTES);
        if (per_cu < 1) { fprintf(stderr, "kernel_launch: occupancy query says %d blocks/CU\n", per_cu); per_cu = 1; }
        (void)hipGetLastError();
        grid = cus * 1;
        fprintf(stderr, "kernel_launch: cus %d per_cu %d grid %d\n", cus, per_cu, grid);
    }
    if (grid < 0) return;
    Args a{};
    const float** p = (const float**)&a;
    for (int i = 0; i < 20; ++i) p[i] = (const float*)d_in[i];
    a.out = (float*)d_out; a.ws = (unsigned char*)d_ws;
    if (hipMemsetAsync((char*)d_ws + WS_CTL, 0, CTL_ZERO_BYTES, stream) != hipSuccess) { fprintf(stderr, "kernel_launch: memset failed\n"); return; }
    hipLaunchKernelGGL(fwd_megakernel, dim3(grid), dim3(NTHR), LDS_BYTES, stream, a);
    const hipError_t e = hipPeekAtLastError();
    if (e != hipSuccess) fprintf(stderr, "launch failed: %s (grid %d)\n", hipGetErrorName(e), grid);
}
```
